# Optimizing an MI355X kernel written in HIP

```python
import math
import jax, jax.numpy as jnp
from jax import lax
import numpy as np

D_MODEL = 1024
BATCH = 2
SEQ = 8192
DEPTH = 4

CHUNK = 64
N_A_LAYERS = DEPTH // 2
N_B_LAYERS = DEPTH - N_A_LAYERS

RET_HEADS = 8
RET_QK_DIM = D_MODEL // RET_HEADS
RET_V_DIM = 2 * RET_QK_DIM
RET_QK_WIDTH = RET_HEADS * RET_QK_DIM
RET_WIDTH = RET_HEADS * RET_V_DIM
RET_IN_WIDTH = 2 * RET_QK_WIDTH + 2 * RET_WIDTH

DIFF_HEADS = 8
DIFF_HEAD_DIM = D_MODEL // (2 * DIFF_HEADS)
DIFF_V_DIM = 2 * DIFF_HEAD_DIM
DIFF_QK_WIDTH = DIFF_HEADS * 2 * DIFF_HEAD_DIM
DIFF_WIDTH = DIFF_HEADS * DIFF_V_DIM
DIFF_IN_WIDTH = DIFF_QK_WIDTH + DIFF_WIDTH
KV_WIDTH = DIFF_QK_WIDTH + DIFF_WIDTH

ROPE_THETA = 10000.0
Q_BLOCK = 128
EPS = 1e-6

kernel_name = "yoco_retention_diffattn_sandwich"


def rmsnorm(x, g):
    xf = x.astype(jnp.float32)
    y = xf * lax.rsqrt(jnp.mean(xf * xf, axis=-1, keepdims=True) + EPS)
    return (y * g.astype(jnp.float32)).astype(x.dtype)


def rope(x):
    s, dim = x.shape[1], x.shape[-1]
    half = dim // 2
    inv = ROPE_THETA ** (-jnp.arange(half, dtype=jnp.float32) / half)
    ang = jnp.arange(s, dtype=jnp.float32)[:, None] * inv[None, :]
    shape = (1, s) + (1,) * (x.ndim - 3) + (half,)
    cos = jnp.cos(ang).reshape(shape)
    sin = jnp.sin(ang).reshape(shape)
    xf = x.astype(jnp.float32)
    x1, x2 = xf[..., :half], xf[..., half:]
    return jnp.concatenate([x1 * cos - x2 * sin, x1 * sin + x2 * cos], axis=-1).astype(x.dtype)


def retention(q, k, v):
    b, s, h, dk = q.shape
    dv = v.shape[-1]
    n = s // CHUNK
    log_gamma = jnp.log1p(-jnp.exp2(-5.0 - jnp.arange(h, dtype=jnp.float32)))
    pos = jnp.arange(CHUNK, dtype=jnp.float32)
    diff = pos[:, None] - pos[None, :]
    decay_mask = jnp.where(diff[None] >= 0,
                           jnp.exp(jnp.maximum(diff, 0.0)[None] * log_gamma[:, None, None]),
                           0.0)
    q_decay = jnp.exp((pos[None, :] + 1.0) * log_gamma[:, None])[:, :, None]
    k_decay = jnp.exp((CHUNK - 1.0 - pos[None, :]) * log_gamma[:, None])[:, :, None]
    chunk_decay = jnp.exp(CHUNK * log_gamma)[None, :, None, None]

    def to_chunks(t):
        return t.astype(jnp.float32).reshape(b, n, CHUNK, h, t.shape[-1]).transpose(1, 0, 3, 2, 4)

    qc = to_chunks(q)
    kc = to_chunks(k) * (dk ** -0.5)
    vc = to_chunks(v)
    scores = jnp.einsum('nbhid,nbhjd->nbhij', qc, kc) * decay_mask[None, None]
    intra = jnp.einsum('nbhij,nbhje->nbhie', scores, vc)

    def step(state, inp):
        q_i, k_i, v_i = inp
        inter = jnp.einsum('bhcd,bhde->bhce', q_i * q_decay, state)
        state = state * chunk_decay + jnp.einsum('bhcd,bhce->bhde', k_i * k_decay, v_i)
        return state, inter

    state0 = jnp.zeros((b, h, dk, dv), jnp.float32)
    _, inter = lax.scan(step, state0, (qc, kc, vc))
    o = (intra + inter).transpose(1, 0, 3, 2, 4).reshape(b, s, h, dv)
    mu = jnp.mean(o, axis=-1, keepdims=True)
    var = jnp.mean(jnp.square(o - mu), axis=-1, keepdims=True)
    return (o - mu) * lax.rsqrt(var + EPS)


def diff_attention(q, k, v, lam):
    b, s, h, _, dh = q.shape
    dv = v.shape[-1]
    nblk = s // Q_BLOCK
    scale = dh ** -0.5
    qb = q.reshape(b, nblk, Q_BLOCK, h, 2, dh).transpose(1, 0, 2, 3, 4, 5)
    kf = k.astype(jnp.float32)
    vf = v.astype(jnp.float32)
    key_chunk = jnp.arange(s) // CHUNK
    neg = jnp.finfo(jnp.float32).min

    def block(args):
        q_i, i = args
        q_chunk = (i * Q_BLOCK + jnp.arange(Q_BLOCK)) // CHUNK
        mask = key_chunk[None, :] <= q_chunk[:, None]
        sc = jnp.einsum('bqhtd,bkhtd->bhtqk', q_i.astype(jnp.float32), kf) * scale
        p = jax.nn.softmax(jnp.where(mask, sc, neg), axis=-1)
        w = p[:, :, 0] - lam * p[:, :, 1]
        return jnp.einsum('bhqk,bkhe->bqhe', w, vf)

    out = lax.map(block, (qb, jnp.arange(nblk)))
    return out.transpose(1, 0, 2, 3, 4).reshape(b, s, h, dv)


def setup_inputs(seed: int = 0) -> dict:
    key = jax.random.key(seed)
    ks = jax.random.split(key, 16)
    f32 = jnp.float32

    def nrm(k, shape, scale):
        return jax.random.normal(k, shape, f32) * scale

    return {
        "x": nrm(ks[0], (BATCH, SEQ, D_MODEL), 1.0),
        "pre_norm": 1.0 + nrm(ks[1], (DEPTH, D_MODEL), 0.02),
        "post_norm": 1.0 + nrm(ks[2], (DEPTH, D_MODEL), 0.02),
        "w_in_a": nrm(ks[3], (N_A_LAYERS, D_MODEL, RET_IN_WIDTH), D_MODEL ** -0.5),
        "w_out_a": nrm(ks[4], (N_A_LAYERS, RET_WIDTH, D_MODEL), RET_WIDTH ** -0.5),
        "kv_norm": 1.0 + nrm(ks[5], (D_MODEL,), 0.02),
        "w_kv": nrm(ks[6], (D_MODEL, KV_WIDTH), D_MODEL ** -0.5),
        "w_in_b": nrm(ks[7], (N_B_LAYERS, D_MODEL, DIFF_IN_WIDTH), D_MODEL ** -0.5),
        "lam_q1": nrm(ks[8], (N_B_LAYERS, DIFF_HEAD_DIM), 0.1),
        "lam_k1": nrm(ks[9], (N_B_LAYERS, DIFF_HEAD_DIM), 0.1),
        "lam_q2": nrm(ks[10], (N_B_LAYERS, DIFF_HEAD_DIM), 0.1),
        "lam_k2": nrm(ks[11], (N_B_LAYERS, DIFF_HEAD_DIM), 0.1),
        "sub_norm_b": 1.0 + nrm(ks[12], (N_B_LAYERS, DIFF_V_DIM), 0.02),
        "w_out_b": nrm(ks[13], (N_B_LAYERS, DIFF_WIDTH, D_MODEL), DIFF_WIDTH ** -0.5),
    }


def reference(x, pre_norm, post_norm, w_in_a, w_out_a, kv_norm, w_kv, w_in_b,
              lam_q1, lam_k1, lam_q2, lam_k2, sub_norm_b, w_out_b):
    b, s, _ = x.shape
    k_shared = None
    v_shared = None
    for layer in range(DEPTH):
        h = rmsnorm(x, pre_norm[layer])
        if layer < N_A_LAYERS:
            proj = h @ w_in_a[layer]
            q = proj[..., :RET_QK_WIDTH].reshape(b, s, RET_HEADS, RET_QK_DIM)
            k = proj[..., RET_QK_WIDTH:2 * RET_QK_WIDTH].reshape(b, s, RET_HEADS, RET_QK_DIM)
            v = proj[..., 2 * RET_QK_WIDTH:2 * RET_QK_WIDTH + RET_WIDTH].reshape(b, s, RET_HEADS, RET_V_DIM)
            gate = proj[..., 2 * RET_QK_WIDTH + RET_WIDTH:]
            o = retention(rope(q), rope(k), v).reshape(b, s, RET_WIDTH)
            y = (o.astype(x.dtype) * jax.nn.silu(gate)) @ w_out_a[layer]
        else:
            j = layer - N_A_LAYERS
            if k_shared is None:
                kv = rmsnorm(x, kv_norm) @ w_kv
                k_shared = rope(kv[..., :DIFF_QK_WIDTH].reshape(b, s, DIFF_HEADS, 2, DIFF_HEAD_DIM))
                v_shared = kv[..., DIFF_QK_WIDTH:].reshape(b, s, DIFF_HEADS, DIFF_V_DIM)
            lambda_init = 0.8 - 0.6 * math.exp(-0.3 * layer)
            lam = (jnp.exp(jnp.sum(lam_q1[j].astype(jnp.float32) * lam_k1[j].astype(jnp.float32)))
                   - jnp.exp(jnp.sum(lam_q2[j].astype(jnp.float32) * lam_k2[j].astype(jnp.float32)))
                   + lambda_init)
            proj = h @ w_in_b[layer - N_A_LAYERS]
            q = rope(proj[..., :DIFF_QK_WIDTH].reshape(b, s, DIFF_HEADS, 2, DIFF_HEAD_DIM))
            gate = proj[..., DIFF_QK_WIDTH:]
            o = diff_attention(q, k_shared, v_shared, lam)
            o = rmsnorm(o, sub_norm_b[j]) * (1.0 - lambda_init)
            o = o.reshape(b, s, DIFF_WIDTH).astype(x.dtype)
            y = (o * jax.nn.silu(gate)) @ w_out_b[j]
        x = x + rmsnorm(y, post_norm[layer])
    return x
```

```cpp
#include <hip/hip_runtime.h>
#include <hip/hip_bf16.h>
#include <cstdio>
#include <cstdint>
#include <cmath>
namespace pg8 {
#define PG8_LAS __attribute__((address_space(3)))
typedef unsigned short bf16_t;
typedef short bf16x8 __attribute__((ext_vector_type(8)));
typedef float f32x4 __attribute__((ext_vector_type(4)));
typedef unsigned u32x4 __attribute__((ext_vector_type(4)));
constexpr int BM = 256, BK = 64, HALF = 128, HTB = HALF * BK * 2  , STAGE_BYTES = 8 * HTB, NXCD = 8, WGM = 8;

__host__ __device__ __forceinline__ int lds_byte(int r, int c) { const int st = (r >> 4) * 2 + (c >> 5), rr = r & 15, cc = c & 31, ob = rr * 64 + cc * 2; return st * 1024 + (ob ^ (((ob >> 9) & 1) << 5)); }
__host__ __device__ __forceinline__ void stage_rc(int b, int& R, int& C) { const int st = b / 1024, sb = b % 1024, swz = sb ^ (((sb >> 9) & 1) << 5); R = (st >> 1) * 16 + swz / 64; C = (st & 1) * 32 + (swz % 64) / 2; }
__host__ __device__ __forceinline__ int perm32(int rho) { const int n = rho >> 4, i = rho & 15; return 8 * (i >> 2) + 4 * n + (i & 3); }

struct Unit { int pm, pn; };
struct Gemm { const bf16_t* A; const bf16_t* Bt; int M, N, K; };

struct StaticOrder {
    int nM, nN, nwg, G, c;
    __host__ __device__ void init(int M, int N, int G_, int c_) { nM = M / BM; nN = N / BM; nwg = nM * nN; G = G_; c = c_; }
    __host__ __device__ bool next(int i, Unit& u) const {
        const long L = (long)i * G + c; if (L >= nwg) return false;
        int wgid = (int)L; { const int q = nwg / NXCD, r = nwg % NXCD, xcd = wgid % NXCD, off = wgid / NXCD; wgid = (xcd < r ? xcd * (q + 1) : r * (q + 1) + (xcd - r) * q) + off; }
        const int nig = WGM * nN, gid = wgid / nig, fm = gid * WGM, gsz = (nM - fm) < WGM ? (nM - fm) : WGM;
        u.pm = fm + ((wgid % nig) % gsz); u.pn = (wgid % nig) / gsz; return true;
    }
    __device__ __forceinline__ void a_ready(const Unit&) const {}
    __device__ __forceinline__ void done(const Unit&) const {}
};

__device__ __forceinline__ unsigned cvt_pk_bf16(float lo, float hi) { unsigned r; asm volatile("v_cvt_pk_bf16_f32 %0, %1, %2" : "=v"(r) : "v"(lo), "v"(hi)); return r; }
typedef float f32x2 __attribute__((ext_vector_type(2)));
__device__ __forceinline__ f32x2 gelu_pk(f32x2 v) {
    const f32x2 av = __builtin_elementwise_abs(v), d = av * 0.2316418882f + 1.0f;
    f32x2 t; t.x = __builtin_amdgcn_rcpf(d.x); t.y = __builtin_amdgcn_rcpf(d.y);
    f32x2 q = t * 0.5307027145f + (-0.7265760135f); q = q * t + 0.7107068705f; q = q * t + (-0.142248368f); q = q * t + 0.127414796f; q = q * t;
    const f32x2 s = (v * v) * (-0.72134752044f);
    f32x2 e; e.x = __builtin_amdgcn_exp2f(s.x); e.y = __builtin_amdgcn_exp2f(s.y);
    const f32x2 m = v * (q * e), r = v - m;
    f32x2 o; o.x = v.x < 0.f ? m.x : r.x; o.y = v.y < 0.f ? m.y : r.y; return o;
}

template <int ACT  > struct EpiBf16 {
    static constexpr bool PERM = true, AFTER_DRAIN = false; static_assert(ACT == 0 || ACT == 1, "EpiBf16: ACT is 0 (none) or 1 (gelu_pk)");
    bf16_t* O; int ldc; const float* bias; int split_cols; size_t split_stride; float scale0;
    __device__ __forceinline__ void operator()(const f32x4 (&acc)[2][2][4][2], const Unit& u, int wr, int wc, int fr, int fq) const {
        const int row0 = u.pm * BM + wr * 64 + fr; int colt = u.pn * BM; bf16_t* base = O;
        float sc = 1.f; if (split_cols) { const int t = colt / split_cols; base += (size_t)t * split_stride; colt -= t * split_cols; if (t == 0) sc = scale0; }
        const int col0 = colt + wc * 32 + 8 * fq, bcol0 = u.pn * BM + wc * 32 + 8 * fq;
        f32x4 bv[2][2];
#pragma unroll
        for (int bj = 0; bj < 2; ++bj)
#pragma unroll
            for (int n = 0; n < 2; ++n) bv[bj][n] = bias ? *(const f32x4*)(bias + bcol0 + bj * HALF + 4 * n) : (f32x4){0.f, 0.f, 0.f, 0.f};
#pragma unroll
        for (int ai = 0; ai < 2; ++ai)
#pragma unroll
            for (int m = 0; m < 4; ++m) { bf16_t* rowp = base + (size_t)(row0 + ai * HALF + m * 16) * ldc + col0;
#pragma unroll
                for (int bj = 0; bj < 2; ++bj) { f32x4 v0 = acc[ai][bj][m][0] + bv[bj][0], v1 = acc[ai][bj][m][1] + bv[bj][1];
                    if (ACT == 1) { f32x2 a = gelu_pk((f32x2){v0[0], v0[1]}), b = gelu_pk((f32x2){v0[2], v0[3]}), c = gelu_pk((f32x2){v1[0], v1[1]}), d = gelu_pk((f32x2){v1[2], v1[3]});
                        v0 = (f32x4){a.x, a.y, b.x, b.y}; v1 = (f32x4){c.x, c.y, d.x, d.y}; }
                    v0 = v0 * sc; v1 = v1 * sc; u32x4 w; w.x = cvt_pk_bf16(v0[0], v0[1]); w.y = cvt_pk_bf16(v0[2], v0[3]); w.z = cvt_pk_bf16(v1[0], v1[1]); w.w = cvt_pk_bf16(v1[2], v1[3]);
                    *(u32x4*)(rowp + bj * HALF) = w; } }
    }
};
typedef __bf16 bf16x2_t __attribute__((ext_vector_type(2)));
__device__ __forceinline__ unsigned pkbf(float lo, float hi) { f32x2 v = {lo, hi}; bf16x2_t b = __builtin_convertvector(v, bf16x2_t); return __builtin_bit_cast(unsigned, b); }
__device__ __forceinline__ float bflo(unsigned u) { return __builtin_bit_cast(float, u << 16); }
__device__ __forceinline__ float bfhi(unsigned u) { return __builtin_bit_cast(float, u & 0xffff0000u); }
__device__ __forceinline__ float silu_f(float x) { return x * __builtin_amdgcn_rcpf(1.0f + __builtin_amdgcn_exp2f(-1.4426950408889634f * x)); }
__device__ __forceinline__ void rope8(f32x4& v0, f32x4& v1, const float* cs, float sc) {
    const f32x4 t0 = *(const f32x4*)cs, t1 = *(const f32x4*)(cs + 4);
    f32x4 o0, o1;
    o0[0] = (v0[0] * t0[0] - v0[1] * t0[1]) * sc; o0[1] = (v0[0] * t0[1] + v0[1] * t0[0]) * sc;
    o0[2] = (v0[2] * t0[2] - v0[3] * t0[3]) * sc; o0[3] = (v0[2] * t0[3] + v0[3] * t0[2]) * sc;
    o1[0] = (v1[0] * t1[0] - v1[1] * t1[1]) * sc; o1[1] = (v1[0] * t1[1] + v1[1] * t1[0]) * sc;
    o1[2] = (v1[2] * t1[2] - v1[3] * t1[3]) * sc; o1[3] = (v1[2] * t1[3] + v1[3] * t1[2]) * sc;
    v0 = o0; v1 = o1;
}
__device__ __forceinline__ u32x4 pack8(const f32x4& v0, const f32x4& v1) { u32x4 w; w.x = pkbf(v0[0], v0[1]); w.y = pkbf(v0[2], v0[3]); w.z = pkbf(v1[0], v1[1]); w.w = pkbf(v1[2], v1[3]); return w; }

struct EpiRet {
    static constexpr bool PERM = true, AFTER_DRAIN = false;
    bf16_t* Q; bf16_t* KD; bf16_t* V; const float* cs128; const float* lgtab;
    __device__ __forceinline__ void operator()(const f32x4 (&acc)[2][2][4][2], const Unit& u, int wr, int wc, int fr, int fq) const {
        const int row0 = u.pm * BM + wr * 64 + fr, pb = wc * 32 + 8 * fq;
        if (u.pn < 8) {
            const bool isk = u.pn >= 4; bf16_t* base = (isk ? KD : Q) + (u.pn & 3) * 256 + pb;
            float lg[2] = {0.f, 0.f}; if (isk) { lg[0] = lgtab[(u.pn - 4) * 2]; lg[1] = lgtab[(u.pn - 4) * 2 + 1]; }
#pragma unroll
            for (int ai = 0; ai < 2; ++ai)
#pragma unroll
                for (int m = 0; m < 4; ++m) { const int row = row0 + ai * HALF + m * 16, pos = row & 8191; const float* cs = cs128 + ((size_t)pos * 64 + (pb >> 1)) * 2;
#pragma unroll
                    for (int bj = 0; bj < 2; ++bj) { float sc = 1.f; if (isk) sc = 0.08838834764831845f * __builtin_amdgcn_exp2f((float)(63 - (pos & 63)) * lg[bj]);
                        f32x4 v0 = acc[ai][bj][m][0], v1 = acc[ai][bj][m][1]; rope8(v0, v1, cs, sc);
                        *(u32x4*)(base + (size_t)row * 1024 + bj * HALF) = pack8(v0, v1); }
                    asm volatile("" ::: "memory"); }
        } else {
            bf16_t* base = V + (u.pn - 8) * 256 + pb;
#pragma unroll
            for (int ai = 0; ai < 2; ++ai)
#pragma unroll
                for (int m = 0; m < 4; ++m) { const int row = row0 + ai * HALF + m * 16;
#pragma unroll
                    for (int bj = 0; bj < 2; ++bj) *(u32x4*)(base + (size_t)row * 2048 + bj * HALF) = pack8(acc[ai][bj][m][0], acc[ai][bj][m][1]); }
        }
    }
};
struct EpiGate {
    static constexpr bool PERM = true, AFTER_DRAIN = false;
    bf16_t* On;
    __device__ __forceinline__ void operator()(const f32x4 (&acc)[2][2][4][2], const Unit& u, int wr, int wc, int fr, int fq) const {
        const int row0 = u.pm * BM + wr * 64 + fr; bf16_t* base = On + u.pn * 256 + wc * 32 + 8 * fq;
#pragma unroll
        for (int ai = 0; ai < 2; ++ai)
#pragma unroll
            for (int m = 0; m < 4; ++m) { const int row = row0 + ai * HALF + m * 16;
#pragma unroll
                for (int bj = 0; bj < 2; ++bj) { u32x4* p = (u32x4*)(base + (size_t)row * 2048 + bj * HALF); const u32x4 o = *p; const f32x4 g0 = acc[ai][bj][m][0], g1 = acc[ai][bj][m][1];
                    f32x4 v0, v1; v0[0] = bflo(o.x) * silu_f(g0[0]); v0[1] = bfhi(o.x) * silu_f(g0[1]); v0[2] = bflo(o.y) * silu_f(g0[2]); v0[3] = bfhi(o.y) * silu_f(g0[3]);
                    v1[0] = bflo(o.z) * silu_f(g1[0]); v1[1] = bfhi(o.z) * silu_f(g1[1]); v1[2] = bflo(o.w) * silu_f(g1[2]); v1[3] = bfhi(o.w) * silu_f(g1[3]);
                    *p = pack8(v0, v1); }
                asm volatile("" ::: "memory"); }
    }
};
struct EpiY {
    static constexpr bool PERM = false, AFTER_DRAIN = false;
    float* Y; int ldc;
    __device__ __forceinline__ void operator()(const f32x4 (&acc)[2][2][4][2], const Unit& u, int wr, int wc, int fr, int fq) const {
        const int row0 = u.pm * BM + wr * 64 + fr; float* base = Y + u.pn * 256 + wc * 32 + 4 * fq;
#pragma unroll
        for (int ai = 0; ai < 2; ++ai)
#pragma unroll
            for (int m = 0; m < 4; ++m) { float* rp = base + (size_t)(row0 + ai * HALF + m * 16) * ldc;
#pragma unroll
                for (int bj = 0; bj < 2; ++bj)
#pragma unroll
                    for (int n = 0; n < 2; ++n) *(f32x4*)(rp + bj * HALF + n * 16) = acc[ai][bj][m][n]; }
    }
};
struct EpiDiff {
    static constexpr bool PERM = true, AFTER_DRAIN = false;
    bf16_t* KS; bf16_t* VS; bf16_t* Q2; bf16_t* G; const float* cs64; int pn_off; float qscale;
    __device__ __forceinline__ void operator()(const f32x4 (&acc)[2][2][4][2], const Unit& u, int wr, int wc, int fr, int fq) const {
        const int row0 = u.pm * BM + wr * 64 + fr, pb = wc * 32 + 8 * fq, t = u.pn + pn_off, ty = t >> 2;
        bf16_t* base = (ty == 0 ? KS : ty == 1 ? VS : ty == 2 ? Q2 : G) + (t & 3) * 256 + pb;
        const float sc = (ty == 2) ? qscale : 1.f;
#pragma unroll
        for (int ai = 0; ai < 2; ++ai)
#pragma unroll
            for (int m = 0; m < 4; ++m) { const int row = row0 + ai * HALF + m * 16, pos = row & 8191; const float* cs = cs64 + ((size_t)pos * 32 + ((pb & 63) >> 1)) * 2;
#pragma unroll
                for (int bj = 0; bj < 2; ++bj) { f32x4 v0 = acc[ai][bj][m][0], v1 = acc[ai][bj][m][1];
                    if (ty == 0 || ty == 2) rope8(v0, v1, cs, sc);
                    else if (ty == 3) {
#pragma unroll
                        for (int e = 0; e < 4; ++e) { v0[e] = silu_f(v0[e]); v1[e] = silu_f(v1[e]); } }
                    *(u32x4*)(base + (size_t)row * 1024 + bj * HALF) = pack8(v0, v1); }
                asm volatile("" ::: "memory"); }
    }
};
template <class Epi, class Sched, bool ALIGN_EPI = false, bool SP2 = false>
__device__ __forceinline__ void gemm_phase(PG8_LAS unsigned char* lds, const Gemm g, const Sched& S, const Epi& E) {
    const int tid = threadIdx.x, wid = __builtin_amdgcn_readfirstlane(tid >> 6), lane = tid & 63, wr = wid >> 2, wc = wid & 3, fr = lane & 15, fq = lane >> 4;
    const int K = g.K, nt = K / BK;
    unsigned voffA[2], voffB[2];
#pragma unroll
    for (int i = 0; i < 2; ++i) { int R, C; stage_rc(tid * 16 + i * 8192, R, C); const int Rb = Epi::PERM ? ((R & ~31) + perm32(R & 31)) : R;
        voffA[i] = (unsigned)(R * K + C) * 2u; voffB[i] = (unsigned)(Rb * K + C) * 2u; }
    const size_t kstep = (size_t)(BK * 2);
    const size_t hstep = (size_t)HALF * K * 2;
    const size_t tstep = 2 * hstep;
    const unsigned ldsw = (unsigned)wid * 1024u;
    const int aoff = lds_byte(wr * 64 + fr, fq * 8), boff = lds_byte(wc * 32 + fr, fq * 8);
#define PG8_SA(b, h) (((b) * 2 + (h)) * HTB)
#define PG8_SB(b, h) ((4 + (b) * 2 + (h)) * HTB)
#define PG8_STAGE(bufoff, gbase, voff) do { _Pragma("unroll") for (int _i = 0; _i < 2; ++_i) \
        __builtin_amdgcn_global_load_lds((const unsigned*)((const char*)(gbase) + (voff)[_i]), (PG8_LAS unsigned*)(lds + (bufoff) + ldsw + _i * 8192), 16, 0, 0); } while (0)
#define PG8_LDA(dst, b, h) do { _Pragma("unroll") for (int m = 0; m < 4; ++m) _Pragma("unroll") for (int k = 0; k < 2; ++k) dst[m][k] = *(const PG8_LAS bf16x8*)(lds + PG8_SA(b, h) + aoff + m * 2048 + k * 1024); } while (0)
#define PG8_LDB(dst, b, h) do { _Pragma("unroll") for (int n = 0; n < 2; ++n) _Pragma("unroll") for (int k = 0; k < 2; ++k) dst[n][k] = *(const PG8_LAS bf16x8*)(lds + PG8_SB(b, h) + boff + n * 2048 + k * 1024); } while (0)
#define PG8_MMA(ai, bj, At, Bt) do { __builtin_amdgcn_s_setprio(1); _Pragma("unroll") for (int m = 0; m < 4; ++m) _Pragma("unroll") for (int n = 0; n < 2; ++n) _Pragma("unroll") for (int k = 0; k < 2; ++k) \
        acc[ai][bj][m][n] = __builtin_amdgcn_mfma_f32_16x16x32_bf16(Bt[n][k], At[m][k], acc[ai][bj][m][n], 0, 0, 0); __builtin_amdgcn_s_setprio(0); } while (0)
#define PG8_WAIT_V(n) asm volatile("s_waitcnt vmcnt(" #n ")" ::: "memory")
#define PG8_WAIT_L(n) asm volatile("s_waitcnt lgkmcnt(" #n ")" ::: "memory")
#define PG8_BAR __builtin_amdgcn_s_barrier()
#define PG8_SCHED __builtin_amdgcn_sched_barrier(0)
    Unit cur, nxt; int ui = 0;
    if (!S.next(0, cur)) return;
    f32x4 acc[2][2][4][2];
#pragma unroll
    for (int a = 0; a < 2; ++a)
#pragma unroll
        for (int b = 0; b < 2; ++b)
#pragma unroll
            for (int m = 0; m < 4; ++m)
#pragma unroll
                for (int n = 0; n < 2; ++n) acc[a][b][m][n] = (f32x4){0.f, 0.f, 0.f, 0.f};
    bf16x8 At[4][2], B0[2][2], B1[2][2];
    const char* cA = (const char*)g.A + (size_t)cur.pm * tstep; const char* cB = (const char*)g.Bt + (size_t)cur.pn * tstep;
    S.a_ready(cur);
    if constexpr (SP2) {
        PG8_STAGE(PG8_SB(0, 0), cB, voffB); PG8_STAGE(PG8_SB(0, 1), cB + hstep, voffB); PG8_STAGE(PG8_SA(0, 0), cA, voffA); PG8_STAGE(PG8_SA(0, 1), cA + hstep, voffA);
        if (wr == 1) PG8_BAR;
        PG8_WAIT_V(2); PG8_BAR;
        PG8_STAGE(PG8_SB(1, 0), cB + kstep, voffB); PG8_STAGE(PG8_SA(1, 0), cA + kstep, voffA); PG8_STAGE(PG8_SB(1, 1), cB + hstep + kstep, voffB);
        PG8_WAIT_V(6); PG8_BAR;
    } else {
        PG8_STAGE(PG8_SB(0, 0), cB, voffB); PG8_STAGE(PG8_SA(0, 0), cA, voffA); PG8_STAGE(PG8_SB(0, 1), cB + hstep, voffB); PG8_STAGE(PG8_SA(0, 1), cA + hstep, voffA);
        if (wr == 1) PG8_BAR;
        PG8_WAIT_V(4); PG8_BAR;
        PG8_STAGE(PG8_SB(1, 0), cB + kstep, voffB); PG8_STAGE(PG8_SA(1, 0), cA + kstep, voffA); PG8_STAGE(PG8_SB(1, 1), cB + hstep + kstep, voffB);
        PG8_WAIT_V(6); PG8_BAR;
    }
    for (;;) {
        const bool has_next = S.next(ui + 1, nxt);
        const char* nA = has_next ? (const char*)g.A + (size_t)nxt.pm * tstep : cA; const char* nB = has_next ? (const char*)g.Bt + (size_t)nxt.pn * tstep : cB;
        for (int t = 0; t < nt; t += 2) {
            const bool last = (t == nt - 2);
            const char* a1 = cA + (size_t)(t + 1) * kstep;
            const char* a2 = last ? nA : cA + (size_t)(t + 2) * kstep; const char* b2 = last ? nB : cB + (size_t)(t + 2) * kstep;
            const char* a3 = a2 + kstep; const char* b3 = b2 + kstep;
            if (last && has_next) S.a_ready(nxt);
            if constexpr (SP2) {
            PG8_LDB(B0, 0, 0); PG8_LDB(B1, 0, 1); PG8_SCHED; PG8_LDA(At, 0, 0); PG8_STAGE(PG8_SA(1, 1), a1 + hstep, voffA);
            PG8_WAIT_V(8); PG8_WAIT_L(0); PG8_BAR; PG8_MMA(0, 0, At, B0); PG8_MMA(0, 1, At, B1); PG8_BAR; PG8_SCHED;
            PG8_LDA(At, 0, 1); PG8_STAGE(PG8_SB(0, 0), b2, voffB); PG8_STAGE(PG8_SB(0, 1), b2 + hstep, voffB); PG8_STAGE(PG8_SA(0, 0), a2, voffA);
            PG8_WAIT_V(8); PG8_WAIT_L(0); PG8_BAR; PG8_MMA(1, 0, At, B0); PG8_MMA(1, 1, At, B1); PG8_BAR; PG8_SCHED;
            PG8_LDB(B0, 1, 0); PG8_LDB(B1, 1, 1); PG8_SCHED; PG8_LDA(At, 1, 0); PG8_STAGE(PG8_SA(0, 1), a2 + hstep, voffA);
            PG8_WAIT_V(8); PG8_WAIT_L(0); PG8_BAR; PG8_MMA(0, 0, At, B0); PG8_MMA(0, 1, At, B1); PG8_BAR; PG8_SCHED;
            PG8_LDA(At, 1, 1); PG8_STAGE(PG8_SB(1, 0), b3, voffB); PG8_STAGE(PG8_SB(1, 1), b3 + hstep, voffB); PG8_STAGE(PG8_SA(1, 0), a3, voffA);
            PG8_WAIT_V(8); PG8_WAIT_L(0); PG8_BAR; PG8_MMA(1, 0, At, B0); PG8_MMA(1, 1, At, B1); PG8_BAR; PG8_SCHED;
            } else {
            PG8_LDB(B0, 0, 0); PG8_SCHED; PG8_LDA(At, 0, 0); PG8_STAGE(PG8_SA(1, 1), a1 + hstep, voffA);
            PG8_WAIT_L(8); PG8_BAR; PG8_WAIT_L(0); PG8_MMA(0, 0, At, B0); PG8_BAR; PG8_SCHED;
            PG8_LDB(B1, 0, 1); PG8_STAGE(PG8_SB(0, 0), b2, voffB);
            PG8_BAR; PG8_WAIT_L(0); PG8_MMA(0, 1, At, B1); PG8_BAR;
            PG8_LDA(At, 0, 1); PG8_STAGE(PG8_SA(0, 0), a2, voffA);
            PG8_BAR; PG8_WAIT_L(0); PG8_MMA(1, 0, At, B0); PG8_BAR; PG8_SCHED;
            PG8_STAGE(PG8_SB(0, 1), b2 + hstep, voffB);
            PG8_WAIT_V(6); PG8_BAR; PG8_MMA(1, 1, At, B1); PG8_BAR;
            PG8_LDB(B0, 1, 0); PG8_SCHED; PG8_LDA(At, 1, 0); PG8_STAGE(PG8_SA(0, 1), a2 + hstep, voffA);
            PG8_WAIT_L(8); PG8_BAR; PG8_WAIT_L(0); PG8_MMA(0, 0, At, B0); PG8_BAR; PG8_SCHED;
            PG8_LDB(B1, 1, 1); PG8_STAGE(PG8_SB(1, 0), b3, voffB);
            PG8_BAR; PG8_WAIT_L(0); PG8_MMA(0, 1, At, B1); PG8_BAR;
            PG8_LDA(At, 1, 1); PG8_STAGE(PG8_SA(1, 0), a3, voffA);
            PG8_BAR; PG8_WAIT_L(0); PG8_MMA(1, 0, At, B0); PG8_BAR; PG8_SCHED;
            PG8_STAGE(PG8_SB(1, 1), b3 + hstep, voffB);
            PG8_WAIT_V(6); PG8_BAR; PG8_MMA(1, 1, At, B1); PG8_BAR;
            }
        }
        if constexpr (ALIGN_EPI) { if (wr == 0) PG8_BAR; }
        if constexpr (!Epi::AFTER_DRAIN) { E(acc, cur, wr, wc, fr, fq); S.done(cur); }
        if (!has_next) break;
#pragma unroll
        for (int a = 0; a < 2; ++a)
#pragma unroll
            for (int b = 0; b < 2; ++b)
#pragma unroll
                for (int m = 0; m < 4; ++m)
#pragma unroll
                    for (int n = 0; n < 2; ++n) acc[a][b][m][n] = (f32x4){0.f, 0.f, 0.f, 0.f};
        cur = nxt; cA = nA; cB = nB; ++ui;
        if constexpr (ALIGN_EPI) { if (wr == 1) PG8_BAR; }
    }
    PG8_WAIT_V(0);
    if constexpr (!ALIGN_EPI) { if (wr == 0) PG8_BAR; }
    PG8_BAR;
    if constexpr (Epi::AFTER_DRAIN) { E.fused(acc, cur, wr, wc, fr, fq, lds, wid, lane); S.done(cur); }
#undef PG8_SA
#undef PG8_SB
#undef PG8_STAGE
#undef PG8_LDA
#undef PG8_LDB
#undef PG8_MMA
#undef PG8_WAIT_V
#undef PG8_WAIT_L
#undef PG8_BAR
#undef PG8_SCHED
}
}
namespace attn_body {
using bf16=__hip_bfloat16;
using bf16x8=__attribute__((ext_vector_type(8)))short;
using s16x4=__attribute__((ext_vector_type(4)))short;
using f32x16=__attribute__((ext_vector_type(16)))float;
using u32x4=__attribute__((ext_vector_type(4)))unsigned;
constexpr int BATCH=2,NHEAD=16,SEQ=8192,D=64,DM=NHEAD*D;
constexpr int NW=8,QBLK=32,QB=QBLK*NW,KVBLK=64,NQB=SEQ/QB;
constexpr int ATTN_PITCH=DM, ATTN_UNIT_ROWS=QB;
__device__ __forceinline__ int crow(int r,int hi){return (r&3)+8*(r>>2)+4*hi;}
#define SBAR() __builtin_amdgcn_sched_barrier(0)
__device__ __forceinline__ void cmask(f32x16&p0,f32x16&p1,int jb,int qrel,int hi){
  const float NEG=-INFINITY; (void)hi;
  if(jb>(qrel>>6)){
  #pragma unroll
  for(int r=0;r<16;++r){p0[r]=NEG;p1[r]=NEG;} }
}

constexpr int NSLOT=3, SLOTB=8192;
constexpr int LDS_K=0, LDS_V=NSLOT*SLOTB, LDS_WS=2*NSLOT*SLOTB, LDS_OST=LDS_WS+NW*64*4, LDS_BYTES=LDS_OST+NW*4096;
constexpr float C2=0.125f*1.4426950408889634f;
__device__ __forceinline__ void glds16(const void*gsrc,unsigned lds_dst){unsigned keep;
  asm volatile("s_mov_b32 %0, m0\n\ts_mov_b32 m0, %2\n\ts_nop 0\n\tglobal_load_lds_dwordx4 %1, off\n\ts_mov_b32 m0, %0":"=&s"(keep):"v"(gsrc),"s"(lds_dst):"memory");}
__device__ __forceinline__ float max3f(float a,float b,float c){float r;asm("v_max3_f32 %0, %1, %2, %3":"=v"(r):"v"(a),"v"(b),"v"(c));return r;}
__device__ __forceinline__ float max2f(float a,float b){float r;asm("v_max_f32_e32 %0, %1, %2":"=v"(r):"v"(a),"v"(b));return r;}
__device__ __forceinline__ float fadd_s(float a,float b){float r;asm("v_add_f32_e32 %0, %1, %2":"=v"(r):"v"(a),"v"(b));return r;}
__device__ __forceinline__ float fsub_s(float a,float b){float r;asm("v_sub_f32_e32 %0, %1, %2":"=v"(r):"v"(a),"v"(b));return r;}
typedef float f32x2_t __attribute__((ext_vector_type(2))); typedef __bf16 bf16x2_t __attribute__((ext_vector_type(2)));
__device__ __forceinline__ unsigned cvtpk_s(float lo,float hi){f32x2_t v={lo,hi};bf16x2_t b=__builtin_convertvector(v,bf16x2_t);return __builtin_bit_cast(unsigned,b);}
#define WAIT_BAR(N) asm volatile("s_waitcnt vmcnt(" #N ") lgkmcnt(0)\n\ts_barrier":::"memory")

__device__ __forceinline__ void qkt(f32x16&p0,f32x16&p1,const char*Kslot,const bf16x8*qr,const f32x16&negm,int r32,int hi){
  const char*kb=Kslot+hi*1024+r32*16;
  #pragma unroll
  for(int d0=0;d0<4;++d0){
    const bf16x8 b0=*reinterpret_cast<const bf16x8*>(kb+d0*2048);
    const bf16x8 b1=*reinterpret_cast<const bf16x8*>(kb+d0*2048+512);
    if(d0==0){p0=__builtin_amdgcn_mfma_f32_32x32x16_bf16(b0,qr[0],negm,0,0,0);p1=__builtin_amdgcn_mfma_f32_32x32x16_bf16(b1,qr[0],negm,0,0,0);}
    else{p0=__builtin_amdgcn_mfma_f32_32x32x16_bf16(b0,qr[d0],p0,0,0,0);p1=__builtin_amdgcn_mfma_f32_32x32x16_bf16(b1,qr[d0],p1,0,0,0);}}
}
typedef __attribute__((address_space(3))) const char* lds_cptr;
typedef short v4i16_t __attribute__((ext_vector_type(4)));
__device__ __forceinline__ void kload8(bf16x8*kf,lds_cptr kp){
  kf[0]=*(const __attribute__((address_space(3))) bf16x8*)(kp);      kf[1]=*(const __attribute__((address_space(3))) bf16x8*)(kp+512);
  kf[2]=*(const __attribute__((address_space(3))) bf16x8*)(kp+2048); kf[3]=*(const __attribute__((address_space(3))) bf16x8*)(kp+2560);
  kf[4]=*(const __attribute__((address_space(3))) bf16x8*)(kp+4096); kf[5]=*(const __attribute__((address_space(3))) bf16x8*)(kp+4608);
  kf[6]=*(const __attribute__((address_space(3))) bf16x8*)(kp+6144); kf[7]=*(const __attribute__((address_space(3))) bf16x8*)(kp+6656);
}
__device__ __forceinline__ void kload2(bf16x8*kf,lds_cptr kp,int j){ kf[2*j]=*(const __attribute__((address_space(3))) bf16x8*)(kp+j*2048); kf[2*j+1]=*(const __attribute__((address_space(3))) bf16x8*)(kp+j*2048+512); }
__device__ __forceinline__ s16x4 vtr(lds_cptr p){ return __builtin_bit_cast(s16x4,__builtin_amdgcn_ds_read_tr16_b64_v4i16((__attribute__((address_space(3))) v4i16_t*)p)); }
__device__ __forceinline__ float rowmax(const f32x16&p0,const f32x16&p1){
  float a=max3f(p0[0],p0[1],p1[0]),b=max3f(p0[2],p0[3],p1[1]);a=max3f(a,p1[2],p1[3]);
  #pragma unroll
  for(int r=4;r<16;r+=4){a=max3f(a,p0[r],p0[r+1]);b=max3f(b,p0[r+2],p0[r+3]);a=max3f(a,p1[r],p1[r+1]);b=max3f(b,p1[r+2],p1[r+3]);}
  const float m=max2f(a,b);
  auto rr=__builtin_amdgcn_permlane32_swap(__float_as_uint(m),__float_as_uint(m),false,false);
  return max2f(__uint_as_float(rr[0]),__uint_as_float(rr[1]));
}
__device__ __forceinline__ void pv(f32x16*o,int vb,bf16x8 pa0,bf16x8 pa1,bf16x8 pa2,bf16x8 pa3){
  #pragma unroll
  for(int d0=0;d0<2;++d0){s16x4 lo[4],hi[4];
    #pragma unroll
    for(int ks=0;ks<4;++ks){
      asm volatile("ds_read_b64_tr_b16 %0,%1 offset:%c2":"=&v"(lo[ks]):"v"(vb),"i"(d0*4096+ks*1024):"memory");
      asm volatile("ds_read_b64_tr_b16 %0,%1 offset:%c2":"=&v"(hi[ks]):"v"(vb),"i"(d0*4096+ks*1024+512):"memory");}
    asm volatile("s_waitcnt lgkmcnt(0)":::"memory");SBAR();
    #define PK(k) (bf16x8){lo[k][0],lo[k][1],lo[k][2],lo[k][3],hi[k][0],hi[k][1],hi[k][2],hi[k][3]}
    o[d0]=__builtin_amdgcn_mfma_f32_32x32x16_bf16(pa0,PK(0),o[d0],0,0,0);
    o[d0]=__builtin_amdgcn_mfma_f32_32x32x16_bf16(pa1,PK(1),o[d0],0,0,0);
    o[d0]=__builtin_amdgcn_mfma_f32_32x32x16_bf16(pa2,PK(2),o[d0],0,0,0);
    o[d0]=__builtin_amdgcn_mfma_f32_32x32x16_bf16(pa3,PK(3),o[d0],0,0,0);
    #undef PK
  }
}

#ifndef ATTN_STORE16
#define ATTN_STORE16(p,v) (*(u32x4*)(p)=(v))
#endif
template<int THRL> __device__ __forceinline__ void attn_unit(int b,int qkcol,int vcol,int qb,const bf16*Q,const bf16*__restrict__ K,const bf16*__restrict__ V,bf16*O,char*shm){
  const int tid=threadIdx.x,lane=tid&63,r32=lane&31,hi=lane>>5; const int wid=__builtin_amdgcn_readfirstlane(tid>>6);
  const long rowbase=(long)b*SEQ; const int q0=qb*QB;
  const bf16*Qw=Q+(rowbase+q0+wid*QBLK)*DM+qkcol;
  const bf16*Kh=K+rowbase*DM+qkcol,*Vh=V+rowbase*DM+vcol;
  const unsigned lds0=(unsigned)(uintptr_t)shm;
  float*wsf=(float*)(shm+LDS_WS)+wid*64;
  const bf16*ksrc=Kh+(long)lane*DM+wid*8;
  const bf16*vsrc=Vh+(long)(16*(wid&3)+(lane>>2))*DM+(wid>>2)*32+(lane&3)*8;
  const unsigned kdst=lds0+LDS_K+wid*1024, vdst=lds0+LDS_V+wid*1024;
  #define DMA_K(t,slot) glds16(ksrc+(long)(t)*KVBLK*DM,(unsigned)__builtin_amdgcn_readfirstlane(kdst+(slot)))
  #define DMA_V(t,slot) glds16(vsrc+(long)(t)*KVBLK*DM,(unsigned)__builtin_amdgcn_readfirstlane(vdst+(slot)))
  const int vb0=(int)(lds0+LDS_V)+((lane>>4)&1)*32+(lane&3)*8+(4*hi+((lane&15)>>2))*64;
  const char*Kbase=shm+LDS_K; bf16x8 kf[8];
  const lds_cptr shm3=(lds_cptr)shm; const lds_cptr kp0=shm3+LDS_K+hi*1024+r32*16; const lds_cptr vp0=shm3+LDS_V+((lane>>4)&1)*32+(lane&3)*8+(4*hi+((lane&15)>>2))*64;
  const int NT=(q0+QB)/KVBLK;
  DMA_K(0,0);DMA_V(0,0);DMA_K(1,SLOTB);
  bf16x8 qr[4];
  #pragma unroll
  for(int d0=0;d0<4;++d0)qr[d0]=*reinterpret_cast<const bf16x8*>(&Qw[(long)r32*DM+d0*16+hi*8]);
  float mhat=0.f,l_reg=0.f;f32x16 o[2];o[0]=f32x16{};o[1]=f32x16{};f32x16 negm=f32x16{};asm volatile("":"+v"(negm));
  const int qrel=wid*QBLK+r32;
  #define CMASK(P0,P1,t) do{int jb_=(t)-(NT-4); if(jb_>=0)cmask(P0,P1,jb_,qrel,hi);}while(0)
  bool resc=false;
  #define START(P0,P1) do{ const float rm=rowmax(P0,P1); resc=false; \
    { const float dl=rm; mhat=fadd_s(mhat,dl); \
      _Pragma("unroll") for(int r=0;r<16;++r){P0[r]=fsub_s(P0[r],dl);P1[r]=fsub_s(P1[r],dl);} \
      _Pragma("unroll") for(int r=0;r<16;++r)negm[r]=-mhat; asm volatile("":"+v"(negm)); } \
    _Pragma("unroll") for(int r=0;r<16;++r)P0[r]=__builtin_amdgcn_exp2f(P0[r]); }while(0)
  #define RESC() do{ if(resc){ asm volatile("s_waitcnt lgkmcnt(0)":::"memory"); \
      _Pragma("unroll") for(int d_=0;d_<2;++d_) _Pragma("unroll") for(int r=0;r<16;++r)o[d_][r]*=wsf[crow(r,hi)]; } }while(0)
  f32x16 pA0,pA1,pB0,pB1;
  int sl_prev=0,sl_cur=0,sl_next=SLOTB;
  #define ROT() do{sl_prev=sl_cur;sl_cur=sl_next;sl_next=(sl_next==(NSLOT-1)*SLOTB)?0:sl_next+SLOTB;}while(0)
  DMA_K(2,2*SLOTB);
  WAIT_BAR(3);
  qkt(pA0,pA1,Kbase,qr,negm,r32,hi);asm volatile("s_nop 15\n\ts_nop 7":"+v"(pA0),"+v"(pA1));CMASK(pA0,pA1,0);
  START(pA0,pA1);
  _Pragma("unroll") for(int r=0;r<16;++r)pA1[r]=__builtin_amdgcn_exp2f(pA1[r]);
  WAIT_BAR(0);
  DMA_K(3,0);DMA_V(1,SLOTB);
  ROT();
  kload8(kf,kp0+sl_cur);
  WAIT_BAR(2);
  s16x4 vlo[8],vhi[8]; u32x4 pw0,pw1,pw2,pw3;
  #define PKW(P,B) cvtpk_s(P[B],P[B+1])
  #define PAF(k) __builtin_bit_cast(bf16x8,pw##k)
  #define VFR(i) (bf16x8){vlo[i][0],vlo[i][1],vlo[i][2],vlo[i][3],vhi[i][0],vhi[i][1],vhi[i][2],vhi[i][3]}
  #define PIN(x) asm volatile("":"+v"(x))
  #define MX3(a,b,c) __builtin_fmaxf(__builtin_fmaxf((a),(b)),(c))
  #define GAPA(MF,A0,A1,A2,A3,W0,W1,PW) do{ MF; sacc+=A0; sacc+=A1; sacc+=A2; sacc+=A3; PIN(sacc); W0; W1; PIN(PW); SBAR(); }while(0)
  #define EX(v) __builtin_amdgcn_exp2f(v)
  #define GAPB(MF,X,B) do{ MF; X[B]=EX(X[B]); X[B+1]=EX(X[B+1]); X[B+2]=EX(X[B+2]); X[B+3]=EX(X[B+3]); PIN(X); SBAR(); }while(0)
  #define VRD(i) do{ vlo[i]=vtr(vp_+(((i)>>2)*4096+((i)&3)*1024)); vhi[i]=vtr(vp_+(((i)>>2)*4096+((i)&3)*1024+512)); }while(0)
  #define KRD(G,j) do{ if(G){ kload2(kf,kp0+sl_next,j); SBAR(); } }while(0)
  #define STEP(C0,C1,P0,P1,t,GK,GV,GL) do{ SBAR(); \
    const lds_cptr vp_=vp0+sl_prev; \
    VRD(0); SBAR(); float sacc=(P0[0]+P0[1]); \
    GAPA(C0=__builtin_amdgcn_mfma_f32_32x32x16_bf16(kf[0],qr[0],negm,0,0,0), P0[2],P0[3],P0[4],P0[5],     pw0[0]=PKW(P0,0), pw0[1]=PKW(P0,2), pw0); \
    VRD(4); SBAR(); GAPA(C1=__builtin_amdgcn_mfma_f32_32x32x16_bf16(kf[1],qr[0],negm,0,0,0), P0[6],P0[7],P0[8],P0[9],     pw0[2]=PKW(P0,4), pw0[3]=PKW(P0,6), pw0); \
    VRD(1); SBAR(); GAPA(C0=__builtin_amdgcn_mfma_f32_32x32x16_bf16(kf[2],qr[1],C0,0,0,0),   P0[10],P0[11],P0[12],P0[13], pw1[0]=PKW(P0,8), pw1[1]=PKW(P0,10), pw1); \
    VRD(5); SBAR(); GAPA(C1=__builtin_amdgcn_mfma_f32_32x32x16_bf16(kf[3],qr[1],C1,0,0,0),   P0[14],P0[15],P1[0],P1[1],   pw1[2]=PKW(P0,12),pw1[3]=PKW(P0,14), pw1); \
    VRD(2); SBAR(); GAPA(C0=__builtin_amdgcn_mfma_f32_32x32x16_bf16(kf[4],qr[2],C0,0,0,0),   P1[2],P1[3],P1[4],P1[5],     pw2[0]=PKW(P1,0), pw2[1]=PKW(P1,2), pw2); \
    VRD(6); SBAR(); GAPA(C1=__builtin_amdgcn_mfma_f32_32x32x16_bf16(kf[5],qr[2],C1,0,0,0),   P1[6],P1[7],P1[8],P1[9],     pw2[2]=PKW(P1,4), pw2[3]=PKW(P1,6), pw2); \
    VRD(3); SBAR(); GAPA(C0=__builtin_amdgcn_mfma_f32_32x32x16_bf16(kf[6],qr[3],C0,0,0,0),   P1[10],P1[11],P1[12],P1[13], pw3[0]=PKW(P1,8), pw3[1]=PKW(P1,10), pw3); \
    VRD(7); SBAR(); GAPA(C1=__builtin_amdgcn_mfma_f32_32x32x16_bf16(kf[7],qr[3],C1,0,0,0),   P1[14],P1[15],0.f,0.f,       pw3[2]=PKW(P1,12),pw3[3]=PKW(P1,14), pw3); \
    l_reg+=sacc; \
    if(GK){DMA_K((t)+3,sl_cur);} if(GV){DMA_V((t)+1,sl_next);} \
    CMASK(C0,C1,t); \
    { float a=MX3(C0[0],C0[1],C1[0]),b=MX3(C0[2],C0[3],C1[1]); a=MX3(a,C1[2],C1[3]); \
      _Pragma("unroll") for(int r=4;r<16;r+=4){a=MX3(a,C0[r],C0[r+1]);b=MX3(b,C0[r+2],C0[r+3]);a=MX3(a,C1[r],C1[r+1]);b=MX3(b,C1[r+2],C1[r+3]);} \
      float rm=__builtin_fmaxf(a,b); { auto rr=__builtin_amdgcn_permlane32_swap(__float_as_uint(rm),__float_as_uint(rm),false,false); rm=__builtin_fmaxf(__uint_as_float(rr[0]),__uint_as_float(rr[1])); } \
      resc=false; \
      if(__builtin_expect(__any(rm>(float)THRL),0)){ const float dl=__builtin_fmaxf(rm,0.f); mhat+=dl; \
        _Pragma("unroll") for(int r=0;r<16;++r){C0[r]-=dl;C1[r]-=dl;} \
        _Pragma("unroll") for(int r=0;r<16;++r)negm[r]=-mhat; asm volatile("":"+v"(negm)); \
        const float f=__builtin_amdgcn_exp2f(-dl); l_reg*=f; if(hi==0)wsf[r32]=f; resc=true; } } \
    SBAR(); \
    GAPB(o[0]=__builtin_amdgcn_mfma_f32_32x32x16_bf16(PAF(0),VFR(0),o[0],0,0,0), C0,0); \
    GAPB(o[1]=__builtin_amdgcn_mfma_f32_32x32x16_bf16(PAF(0),VFR(4),o[1],0,0,0), C0,4); \
    KRD(GL,0); GAPB(o[0]=__builtin_amdgcn_mfma_f32_32x32x16_bf16(PAF(1),VFR(1),o[0],0,0,0), C0,8); \
    KRD(GL,1); GAPB(o[1]=__builtin_amdgcn_mfma_f32_32x32x16_bf16(PAF(1),VFR(5),o[1],0,0,0), C0,12); \
    KRD(GL,2); GAPB(o[0]=__builtin_amdgcn_mfma_f32_32x32x16_bf16(PAF(2),VFR(2),o[0],0,0,0), C1,0); \
    KRD(GL,3); GAPB(o[1]=__builtin_amdgcn_mfma_f32_32x32x16_bf16(PAF(2),VFR(6),o[1],0,0,0), C1,4); \
    GAPB(o[0]=__builtin_amdgcn_mfma_f32_32x32x16_bf16(PAF(3),VFR(3),o[0],0,0,0), C1,8); \
    GAPB(o[1]=__builtin_amdgcn_mfma_f32_32x32x16_bf16(PAF(3),VFR(7),o[1],0,0,0), C1,12); \
    }while(0)
  int t=1;
  #undef CMASK
  #define CMASK(P0,P1,t) do{}while(0)
  for(;t+5<NT;t+=2){
    STEP(pB0,pB1,pA0,pA1,t,true,true,true);     WAIT_BAR(2); RESC(); ROT();
    STEP(pA0,pA1,pB0,pB1,t+1,true,true,true);   WAIT_BAR(2); RESC(); ROT();
  }
  #undef CMASK
  #define CMASK(P0,P1,t) do{int jb_=(t)-(NT-4); if(jb_>=0)cmask(P0,P1,jb_,qrel,hi);}while(0)
  #define ENDW(tt) do{ if((tt)+3<NT){WAIT_BAR(2);} else if((tt)+2<NT){WAIT_BAR(1);} else {WAIT_BAR(0);} }while(0)
  for(;t+1<NT;t+=2){
    STEP(pB0,pB1,pA0,pA1,t,(t+3<NT),(t+1<NT),(t+1<NT));       ENDW(t);   RESC(); ROT();
    STEP(pA0,pA1,pB0,pB1,t+1,(t+4<NT),(t+2<NT),(t+2<NT));     ENDW(t+1); RESC(); ROT();
  }
  STEP(pB0,pB1,pA0,pA1,NT-1,false,false,false); RESC();
  { float sacc=pB0[0]+pB0[1]; _Pragma("unroll") for(int r=2;r<16;++r)sacc+=pB0[r]; _Pragma("unroll") for(int r=0;r<16;++r)sacc+=pB1[r]; l_reg+=sacc;
    pw0=(u32x4){PKW(pB0,0),PKW(pB0,2),PKW(pB0,4),PKW(pB0,6)};pw1=(u32x4){PKW(pB0,8),PKW(pB0,10),PKW(pB0,12),PKW(pB0,14)};pw2=(u32x4){PKW(pB1,0),PKW(pB1,2),PKW(pB1,4),PKW(pB1,6)};pw3=(u32x4){PKW(pB1,8),PKW(pB1,10),PKW(pB1,12),PKW(pB1,14)};
    SBAR(); pv(o,vb0+sl_cur,PAF(0),PAF(1),PAF(2),PAF(3)); }
  #undef PKW
  #undef PAF
  #undef VFR
  #undef PIN
  #undef MX3
  #undef GAPA
  #undef GAPB
  #undef EX
  #undef VRD
  #undef KRD
  #undef STEP
  #undef ENDW
  {auto rr=__builtin_amdgcn_permlane32_swap(__float_as_uint(l_reg),__float_as_uint(l_reg),false,false);l_reg=__uint_as_float(rr[0])+__uint_as_float(rr[1]);}
  if(hi==0)wsf[32+r32]=l_reg;asm volatile("s_waitcnt lgkmcnt(0)":::"memory");
  float rli[16];
  #pragma unroll
  for(int r=0;r<16;++r)rli[r]=__builtin_amdgcn_rcpf(wsf[32+crow(r,hi)]);
  bf16*Ow=O+(rowbase+q0+wid*QBLK)*DM+vcol;
  { bf16*stg=(bf16*)(shm+LDS_OST)+wid*2048;
    #pragma unroll
    for(int r=0;r<16;++r){const int orow=crow(r,hi);
      #pragma unroll
      for(int d0=0;d0<2;++d0)stg[orow*64+d0*32+r32]=__float2bfloat16(o[d0][r]*rli[r]);}
    asm volatile("s_waitcnt lgkmcnt(0)":::"memory");
    #pragma unroll
    for(int i=0;i<4;++i){const int row=i*8+(lane>>3),ch=lane&7; const u32x4 v=*(const u32x4*)(stg+row*64+ch*8); ATTN_STORE16(Ow+(long)row*DM+ch*8,v);} }
  asm volatile("s_waitcnt lgkmcnt(0)\n\ts_barrier":::"memory");
  #undef DMA_K
  #undef DMA_V
  #undef CMASK
  #undef START
  #undef RESC
  #undef ROT
}
constexpr int ATTN_LDS_BYTES=LDS_BYTES;
struct AttnTensors { const bf16* Q; const bf16* K; const bf16* V; bf16* O0; bf16* O1; };
struct AttnUnit { int bh; int vh; int qb; };
struct StaticOrder {
  int vcu;
  __device__ __forceinline__ explicit StaticOrder(int grid,int block):vcu((block%8)*(grid/8)+block/8){}
  __device__ __forceinline__ bool next(int i,AttnUnit&u)const{ if(i>=8)return false; const int s=vcu&7,k=i&3; u.bh=vcu>>3; u.vh=i>>2; u.qb=(k==0)?s:(k==1)?15-s:(k==2)?16+s:31-s; return true; }
};
template<class Sched,int THRL=8> __device__ __forceinline__ void attn_phase(char*lds,const AttnTensors&T,const Sched&S){
  AttnUnit u;
  for(int i=0;S.next(i,u);++i){ const int b=u.bh/NHEAD,hh=u.bh%NHEAD; attn_unit<THRL>(b,hh*64,(hh>>1)*128+u.vh*64,u.qb,T.Q,T.K,T.V,(hh&1)?T.O1:T.O0,lds); }
}
#undef SBAR
#undef WAIT_BAR
}
#define GAS __attribute__((address_space(1)))
#define LAS __attribute__((address_space(3)))
typedef unsigned short bf16;
typedef unsigned v4u __attribute__((ext_vector_type(4)));
typedef float f32x4 __attribute__((ext_vector_type(4)));
typedef short bf16x8 __attribute__((ext_vector_type(8)));
typedef GAS unsigned gu32;
typedef GAS unsigned long long gu64;
#define RLX_AGENT __ATOMIC_RELAXED, __HIP_MEMORY_SCOPE_AGENT
#define LDS_WAIT() asm volatile("s_waitcnt lgkmcnt(0)" ::: "memory")
#define VM_WAIT() asm volatile("s_waitcnt vmcnt(0)" ::: "memory")
__device__ __forceinline__ unsigned long long rt() { return __builtin_amdgcn_s_memrealtime(); }
__device__ __forceinline__ unsigned f2bf(float f) { unsigned u = __builtin_bit_cast(unsigned, f); return (u + 0x7fffu + ((u >> 16) & 1u)) >> 16; }
__device__ __forceinline__ unsigned pk2(float lo, float hi) { return f2bf(lo) | (f2bf(hi) << 16); }

#define XB_TMO      128
#define XB_XCNT(j)  (256  + 64 * (j))
#define XB_XSUB(j)  (1280 + 64 * (j))
#define XB_XGEN(j)  (2304 + 64 * (j))
#define XB_TOP      3328
#define XB_TOPGEN   3392
#define XCD_BAR_WORDS 3456
#define XB_SPIN_CAP (1u << 18)

__device__ __forceinline__ unsigned xb_ld(unsigned* p)              { return __hip_atomic_load(p, __ATOMIC_RELAXED, __HIP_MEMORY_SCOPE_AGENT); }
__device__ __forceinline__ unsigned xb_add(unsigned* p, unsigned v) { return __hip_atomic_fetch_add(p, v, __ATOMIC_RELAXED, __HIP_MEMORY_SCOPE_AGENT); }
__device__ __forceinline__ unsigned xb_xcc_id() { return (unsigned)__builtin_amdgcn_s_getreg((3 << 11) | 20) & 0xFu; }
#define XB_SPIN(cond, bar) do { unsigned _sp = 0; while (cond) { __builtin_amdgcn_s_sleep(1); \
    if ((++_sp & 255u) == 0u) { if (xb_ld(&(bar)[XB_TMO])) break; if (_sp > XB_SPIN_CAP) { atomicAdd(&(bar)[XB_TMO], 1u); break; } } } } while (0)

struct XcdBarrier {
    unsigned* bar; unsigned x;
    volatile LAS unsigned* st;
};

__device__ __forceinline__ XcdBarrier xcd_barrier_post(unsigned* bar, volatile LAS unsigned* st) {
    XcdBarrier b; b.bar = bar; b.x = xb_xcc_id(); b.st = st;
    if (threadIdx.x == 0) (void)xb_add(&bar[XB_XCNT(b.x)], 1u);
    return b;
}
__device__ __forceinline__ void xcd_barrier_complete(unsigned* bar, unsigned x, unsigned& nloc, unsigned& nx) {
    const unsigned G = gridDim.x * gridDim.y * gridDim.z;
    unsigned sum, cnt, mine, sp = 0u;
    for (;;) {
        sum = 0u; cnt = 0u; mine = 0u;
#pragma unroll
        for (unsigned j = 0; j < 16; ++j) { const unsigned c = xb_ld(&bar[XB_XCNT(j)]); sum += c; cnt += (c > 0u) ? 1u : 0u; mine = (j == x) ? c : mine; }
        if (sum == G) break;
        __builtin_amdgcn_s_sleep(1);
        if ((++sp & 255u) == 0u) { if (xb_ld(&bar[XB_TMO])) break; if (sp > XB_SPIN_CAP) { atomicAdd(&bar[XB_TMO], 1u); break; } }
    }
    nloc = mine > 0u ? mine : 1u; nx = cnt > 0u ? cnt : 1u;
}

__device__ __forceinline__ void xcd_barrier(const XcdBarrier& b) {
    asm volatile("s_waitcnt vmcnt(0)" ::: "memory");
    __syncthreads();
    if (threadIdx.x == 0) {
        unsigned* bar = b.bar;
        __builtin_amdgcn_s_waitcnt(0);
        unsigned nloc = b.st[0], nx = b.st[1];
        if (nloc == 0u) { xcd_barrier_complete(bar, b.x, nloc, nx); b.st[0] = nloc; b.st[1] = nx; }
        const unsigned old = xb_add(&bar[XB_XSUB(b.x)], 1u);
        const unsigned gen = old / nloc;
        if (old + 1u == (gen + 1u) * nloc) {
            __builtin_amdgcn_fence(__ATOMIC_RELEASE, "agent");
            asm volatile("s_waitcnt vmcnt(0)" ::: "memory");
            const unsigned og = xb_add(&bar[XB_TOP], 1u);
            const unsigned tg = og / nx;
            if (og + 1u == (tg + 1u) * nx) xb_add(&bar[XB_TOPGEN], 1u);
            else XB_SPIN(xb_ld(&bar[XB_TOPGEN]) == tg, bar);
            __builtin_amdgcn_fence(__ATOMIC_ACQUIRE, "agent");
            xb_add(&bar[XB_XGEN(b.x)], 1u);
            asm volatile("s_waitcnt vmcnt(0)" ::: "memory");
        } else {
            XB_SPIN(xb_ld(&bar[XB_XGEN(b.x)]) == gen, bar);
            __builtin_amdgcn_fence(__ATOMIC_ACQUIRE, "agent");
            asm volatile("s_waitcnt vmcnt(0)" ::: "memory");
        }
    }
    __syncthreads();
}
namespace ret {
#define RLAS __attribute__((address_space(3)))
typedef unsigned short bf16_t;
typedef float f32x16 __attribute__((ext_vector_type(16)));
typedef float f32x4 __attribute__((ext_vector_type(4)));
typedef float f32x2 __attribute__((ext_vector_type(2)));
typedef short bf16x8 __attribute__((ext_vector_type(8)));
typedef short s16x4 __attribute__((ext_vector_type(4)));
typedef unsigned u32x4 __attribute__((ext_vector_type(4)));
typedef unsigned u32x2 __attribute__((ext_vector_type(2)));
typedef __bf16 bf16x2_t __attribute__((ext_vector_type(2)));
constexpr int QS = 272, KRS = 272, KTS = 320, VTS = 576;
constexpr int L_Q = 0, L_KR = 64 * QS, L_KT = L_KR + 64 * KRS, L_V = L_KT + 64 * KTS, L_ST = L_V + 64 * VTS, L_END = L_ST + 8 * 64 * 8;
constexpr float GN_EPS = 1e-6f;
__device__ __forceinline__ unsigned pkbf(float lo, float hi) { f32x2 v = {lo, hi}; bf16x2_t b = __builtin_convertvector(v, bf16x2_t); return __builtin_bit_cast(unsigned, b); }
template <int S> __device__ __forceinline__ bf16x8 cvt8(const f32x16& x) {
    u32x4 w; w.x = pkbf(x[8 * S + 0], x[8 * S + 1]); w.y = pkbf(x[8 * S + 2], x[8 * S + 3]); w.z = pkbf(x[8 * S + 4], x[8 * S + 5]); w.w = pkbf(x[8 * S + 6], x[8 * S + 7]);
    return __builtin_bit_cast(bf16x8, w);
}
__device__ __forceinline__ bf16x8 trfrag(RLAS const unsigned char* p, int step8) {
    typedef short v4i16_t __attribute__((ext_vector_type(4)));
    const s16x4 lo = __builtin_bit_cast(s16x4, __builtin_amdgcn_ds_read_tr16_b64_v4i16((RLAS v4i16_t*)p));
    const s16x4 hi = __builtin_bit_cast(s16x4, __builtin_amdgcn_ds_read_tr16_b64_v4i16((RLAS v4i16_t*)(p + step8)));
    return (bf16x8){lo[0], lo[1], lo[2], lo[3], hi[0], hi[1], hi[2], hi[3]};
}
#define RMFMA(a, b, c) __builtin_amdgcn_mfma_f32_32x32x16_bf16(a, b, c, 0, 0, 0)

struct Bufs { const bf16_t* Q; const bf16_t* KD; bf16_t* V; float* L; const float* lgtab; };

template <bool FULL> __device__ __forceinline__ void stage(RLAS unsigned char* lds, const Bufs& B, size_t row0, int h, int tid) {
    u32x4 kq[2], kk[2], vv[4];
#pragma unroll
    for (int i = 0; i < 2; ++i) { const int piece = tid + 512 * i, row = piece >> 4, ch = piece & 15; const size_t off = (row0 + row) * 1024 + h * 128 + ch * 8;
        kk[i] = *(const u32x4*)(B.KD + off); if (FULL) kq[i] = *(const u32x4*)(B.Q + off); }
#pragma unroll
    for (int i = 0; i < 4; ++i) { const int piece = tid + 512 * i, row = piece >> 5, ch = piece & 31; vv[i] = *(const u32x4*)(B.V + (row0 + row) * 2048 + h * 256 + ch * 8); }
#pragma unroll
    for (int i = 0; i < 2; ++i) { const int piece = tid + 512 * i, row = piece >> 4, ch = piece & 15;
        *(RLAS u32x4*)(lds + L_KT + row * KTS + ch * 16) = kk[i];
        if (FULL) { *(RLAS u32x4*)(lds + L_KR + row * KRS + ch * 16) = kk[i]; *(RLAS u32x4*)(lds + L_Q + row * QS + ch * 16) = kq[i]; } }
#pragma unroll
    for (int i = 0; i < 4; ++i) { const int piece = tid + 512 * i, row = piece >> 5, ch = piece & 31; *(RLAS u32x4*)(lds + L_V + row * VTS + ch * 16) = vv[i]; }
}

__device__ __forceinline__ void state_update(f32x16 (&st)[4], const bf16x8 (&vf)[4], RLAS const unsigned char* kbase, float cd) {
#pragma unroll
    for (int dt = 0; dt < 4; ++dt) st[dt] = st[dt] * cd;
#pragma unroll
    for (int ks = 0; ks < 4; ++ks)
#pragma unroll
        for (int dt = 0; dt < 4; ++dt) { const bf16x8 a = trfrag(kbase + ks * 16 * KTS + dt * 64, 8 * KTS); st[dt] = RMFMA(a, vf[ks], st[dt]); }
    __builtin_amdgcn_sched_barrier(0);
}

__device__ __forceinline__ void r1_unit(RLAS unsigned char* lds, const Bufs& B, int unit) {
    const int tid = threadIdx.x, lane = tid & 63, w = __builtin_amdgcn_readfirstlane(tid >> 6), hh = lane >> 5, g1 = (lane >> 4) & 1, q = (lane & 15) >> 2, p = lane & 3;
    const int g = unit & 15, h = (unit >> 4) & 7, b = unit >> 7;
    const float lg = B.lgtab[h], cd = __builtin_amdgcn_exp2f(64.f * lg);
    RLAS const unsigned char* vbase = lds + L_V + (4 * hh + q) * VTS + (32 * w + 16 * g1 + 4 * p) * 2;
    RLAS const unsigned char* kbase = lds + L_KT + (4 * hh + q) * KTS + (16 * g1 + 4 * p) * 2;
    f32x16 st[4];
#pragma unroll
    for (int dt = 0; dt < 4; ++dt)
#pragma unroll
        for (int e = 0; e < 16; ++e) st[dt][e] = 0.f;
    const size_t row0 = (size_t)b * 8192 + (size_t)g * 512;
    for (int j = 0; j < 8; ++j) {
        __syncthreads();
        stage<false>(lds, B, row0 + 64 * j, h, tid);
        __syncthreads();
        bf16x8 vf[4];
#pragma unroll
        for (int ks = 0; ks < 4; ++ks) vf[ks] = trfrag(vbase + ks * 16 * VTS, 8 * VTS);
        state_update(st, vf, kbase, cd);
    }
    float* Lp = B.L + ((size_t)unit * 8 + w) * 4096 + lane * 4;
#pragma unroll
    for (int dt = 0; dt < 4; ++dt)
#pragma unroll
        for (int k4 = 0; k4 < 4; ++k4) *(f32x4*)(Lp + (dt * 4 + k4) * 256) = (f32x4){st[dt][4 * k4], st[dt][4 * k4 + 1], st[dt][4 * k4 + 2], st[dt][4 * k4 + 3]};
}

__device__ __forceinline__ void r3_unit(RLAS unsigned char* lds, const Bufs& B, int unit) {
    const int tid = threadIdx.x, lane = tid & 63, w = __builtin_amdgcn_readfirstlane(tid >> 6), r = lane & 31, hh = lane >> 5, g1 = (lane >> 4) & 1, q = (lane & 15) >> 2, p = lane & 3;
    const int g = unit & 15, h = (unit >> 4) & 7, b = unit >> 7;
    const float lg = B.lgtab[h], cd = __builtin_amdgcn_exp2f(64.f * lg), cd8 = __builtin_amdgcn_exp2f(512.f * lg);
    float qdec[2], smask[2];
#pragma unroll
    for (int ct = 0; ct < 2; ++ct) { const float c = (float)(32 * ct + r); qdec[ct] = __builtin_amdgcn_exp2f((c + 1.f) * lg); smask[ct] = __builtin_amdgcn_exp2f((c - 63.f) * lg); }
    RLAS const unsigned char* vbase = lds + L_V + (4 * hh + q) * VTS + (32 * w + 16 * g1 + 4 * p) * 2;
    RLAS const unsigned char* kbase = lds + L_KT + (4 * hh + q) * KTS + (16 * g1 + 4 * p) * 2;
    RLAS const unsigned char* qrow = lds + L_Q + r * QS + hh * 16;
    RLAS const unsigned char* krow = lds + L_KR + r * KRS + hh * 16;
    RLAS const unsigned char* qprm = lds + L_Q + r * QS + hh * 8;
    RLAS f32x2* ST = (RLAS f32x2*)(lds + L_ST);
    f32x16 st[4];
#pragma unroll
    for (int dt = 0; dt < 4; ++dt)
#pragma unroll
        for (int e = 0; e < 16; ++e) st[dt][e] = 0.f;
    for (int gp = 0; gp < g; ++gp) {
        const float* Lp = B.L + ((size_t)(unit - g + gp) * 8 + w) * 4096 + lane * 4;
#pragma unroll
        for (int dt = 0; dt < 4; ++dt)
#pragma unroll
            for (int k4 = 0; k4 < 4; ++k4) { const f32x4 v = *(const f32x4*)(Lp + (dt * 4 + k4) * 256);
#pragma unroll
                for (int e = 0; e < 4; ++e) st[dt][4 * k4 + e] = st[dt][4 * k4 + e] * cd8 + v[e]; }
    }
    const size_t row0 = (size_t)b * 8192 + (size_t)g * 512;
    for (int j = 0; j < 8; ++j) {
        __syncthreads();
        stage<true>(lds, B, row0 + 64 * j, h, tid);
        __syncthreads();
        bf16x8 vf[4];
#pragma unroll
        for (int ks = 0; ks < 4; ++ks) vf[ks] = trfrag(vbase + ks * 16 * VTS, 8 * VTS);
        f32x16 oT[2];
#pragma unroll
        for (int ct = 0; ct < 2; ++ct)
#pragma unroll
            for (int e = 0; e < 16; ++e) oT[ct][e] = 0.f;
#pragma unroll
        for (int dt = 0; dt < 4; ++dt) {
            const bf16x8 a0 = cvt8<0>(st[dt]), a1 = cvt8<1>(st[dt]);
#pragma unroll
            for (int ct = 0; ct < 2; ++ct) {
                RLAS const unsigned char* qp = qprm + ct * 32 * QS + dt * 64;
                const u32x2 l0 = *(RLAS const u32x2*)(qp), h0 = *(RLAS const u32x2*)(qp + 16), l1 = *(RLAS const u32x2*)(qp + 32), h1 = *(RLAS const u32x2*)(qp + 48);
                const bf16x8 b0 = __builtin_bit_cast(bf16x8, (u32x4){l0.x, l0.y, h0.x, h0.y}), b1 = __builtin_bit_cast(bf16x8, (u32x4){l1.x, l1.y, h1.x, h1.y});
                oT[ct] = RMFMA(a0, b0, oT[ct]); oT[ct] = RMFMA(a1, b1, oT[ct]);
            }
            __builtin_amdgcn_sched_barrier(0);
        }
#pragma unroll
        for (int ct = 0; ct < 2; ++ct) oT[ct] = oT[ct] * qdec[ct];
#pragma unroll
        for (int ct = 0; ct < 2; ++ct)
#pragma unroll
            for (int ctp = 0; ctp <= ct; ++ctp) {
                f32x16 sT;
#pragma unroll
                for (int e = 0; e < 16; ++e) sT[e] = 0.f;
#pragma unroll
                for (int ks = 0; ks < 8; ++ks) { const bf16x8 a = *(RLAS const bf16x8*)(krow + ctp * 32 * KRS + ks * 32), bq = *(RLAS const bf16x8*)(qrow + ct * 32 * QS + ks * 32); sT = RMFMA(a, bq, sT); }
#pragma unroll
                for (int e = 0; e < 16; ++e) { const int cp = (e & 3) + 8 * (e >> 2) + 4 * hh; const bool keep = (ctp < ct) || (cp <= r); sT[e] = keep ? sT[e] * smask[ct] : 0.f; }
                oT[ct] = RMFMA(vf[2 * ctp], cvt8<0>(sT), oT[ct]); oT[ct] = RMFMA(vf[2 * ctp + 1], cvt8<1>(sT), oT[ct]);
                __builtin_amdgcn_sched_barrier(0);
            }
#pragma unroll
        for (int ct = 0; ct < 2; ++ct) { float s1 = 0.f, s2 = 0.f;
#pragma unroll
            for (int e = 0; e < 16; ++e) { s1 += oT[ct][e]; s2 += oT[ct][e] * oT[ct][e]; }
            s1 += __shfl_xor(s1, 32); s2 += __shfl_xor(s2, 32);
            if (hh == 0) ST[w * 64 + 32 * ct + r] = (f32x2){s1, s2}; }
        __syncthreads();
#pragma unroll
        for (int ct = 0; ct < 2; ++ct) { float s1 = 0.f, s2 = 0.f;
#pragma unroll
            for (int ww = 0; ww < 8; ++ww) { const f32x2 t = ST[ww * 64 + 32 * ct + r]; s1 += t.x; s2 += t.y; }
            const float mean = s1 * (1.f / 256.f), var = fmaxf(s2 * (1.f / 256.f) - mean * mean, 0.f), rstd = 1.0f / sqrtf(var + GN_EPS);
            bf16_t* op = B.V + (row0 + 64 * j + 32 * ct + r) * 2048 + h * 256 + 32 * w + 4 * hh;
#pragma unroll
            for (int k4 = 0; k4 < 4; ++k4) { u32x2 o; o.x = pkbf((oT[ct][4 * k4] - mean) * rstd, (oT[ct][4 * k4 + 1] - mean) * rstd); o.y = pkbf((oT[ct][4 * k4 + 2] - mean) * rstd, (oT[ct][4 * k4 + 3] - mean) * rstd);
                *(u32x2*)(op + 8 * k4) = o; } }
        state_update(st, vf, kbase, cd);
    }
}
#undef RMFMA
#undef RLAS
}
constexpr int NWAVES = 8;
constexpr int BATCH = 2, SEQ = 8192, DM = 1024, M = BATCH * SEQ;
constexpr float EPS = 1e-6f;
constexpr float C2 = 0.125f * 1.4426950408889634f;
constexpr float LAMBDA_INIT2 = 0.4707130183384360f;
constexpr float LAMBDA_INIT3 = 0.5560582041564060f;

constexpr size_t MiB = 1u << 20;
constexpr size_t WS_CTL = 0, CTL_ZERO_BYTES = 64 * 1024;
constexpr size_t WS_MISC = 512 * 1024;
constexpr size_t WS_CS128 = 1 * MiB;
constexpr size_t WS_CS64 = 5 * MiB;
constexpr size_t WS_WINA = 8 * MiB;
constexpr size_t WS_WOUTA = 32 * MiB;
constexpr size_t WS_WKVQ = 40 * MiB;
constexpr size_t WS_W3 = 48 * MiB;
constexpr size_t WS_WOUTB = 52 * MiB;
constexpr size_t WS_XN = 56 * MiB;
constexpr size_t WS_R = 88 * MiB;
constexpr size_t WS_L = 216 * MiB;
constexpr size_t WS_END = 248 * MiB;
constexpr int CW_BAR = 1024;

constexpr int RING_OFF = 0, RING_BYTES = 131072;
constexpr int LDSCTL_OFF = RING_BYTES, MISC_OFF = LDSCTL_OFF + 320;
constexpr int LDS_BYTES = 147456;

struct Args {
    const float* x; const float* pre_norm; const float* post_norm; const float* w_in_a; const float* w_out_a; const float* kv_norm; const float* w_kv; const float* w_in_b;
    const float* lam_q1; const float* lam_k1; const float* lam_q2; const float* lam_k2; const float* sub_norm_b; const float* w_out_b;
    float* out; unsigned char* ws; int ph_lo, ph_hi, use_bar, pad;
};

__device__ __forceinline__ float wave_sum(float v) {
#pragma unroll
    for (int o = 1; o < 64; o <<= 1) v += __shfl_xor(v, o);
    return v;
}
__device__ __forceinline__ unsigned pkbf(float lo, float hi) { return pg8::pkbf(lo, hi); }

template <int PERM> __device__ __forceinline__ void transpose_item(const float* W, int ldw, int c0, int ncols, int K, const float* gain, bf16* WT, int row_off, int plim, LAS float* scr, int item, int lane) {
    const int nblk = ncols / 32, kb = item / nblk, nb = item % nblk, k0 = 64 * kb, n0 = 32 * nb;
#pragma unroll 8
    for (int i = 0; i < 32; ++i) { const int kk = 2 * i + (lane >> 5); float v = W[(size_t)(k0 + kk) * ldw + c0 + n0 + (lane & 31)]; if (gain) v *= gain[k0 + kk]; scr[kk * 33 + (lane & 31)] = v; }
    LDS_WAIT(); asm volatile("" ::: "memory");
    const int c = lane & 7;
#pragma unroll
    for (int j = 0; j < 4; ++j) { const int n = (lane >> 3) + 8 * j, nn = n0 + n; const LAS float* s = scr + (8 * c) * 33 + n;
        int dr = nn;
        if (PERM == 1 && nn < plim) dr = (nn & ~127) | (2 * (nn & 63) + ((nn >> 6) & 1));
        if (PERM == 2 && nn < plim) dr = (nn & ~63) | (2 * (nn & 31) + ((nn >> 5) & 1));
        v4u o; o.x = pkbf(s[0 * 33], s[1 * 33]); o.y = pkbf(s[2 * 33], s[3 * 33]); o.z = pkbf(s[4 * 33], s[5 * 33]); o.w = pkbf(s[6 * 33], s[7 * 33]);
        *(GAS v4u*)(WT + (size_t)(row_off + dr) * K + k0 + 8 * c) = o; }
    LDS_WAIT(); asm volatile("" ::: "memory");
}
__device__ __forceinline__ void row_to_xn(const float* xrow, bf16* orow, int lane) {
    const GAS f32x4* xr = (const GAS f32x4*)xrow + lane;
    f32x4 v[4]; float s = 0.f;
#pragma unroll
    for (int j = 0; j < 4; ++j) { v[j] = xr[64 * j]; s += (v[j].x * v[j].x + v[j].y * v[j].y) + (v[j].z * v[j].z + v[j].w * v[j].w); }
    const float rstd = 1.f / sqrtf(wave_sum(s) * (1.f / DM) + EPS);
    GAS unsigned long long* o8 = (GAS unsigned long long*)orow + lane;
#pragma unroll
    for (int j = 0; j < 4; ++j) o8[64 * j] = (unsigned long long)pkbf(v[j].x * rstd, v[j].y * rstd) | ((unsigned long long)pkbf(v[j].z * rstd, v[j].w * rstd) << 32);
}
__device__ __forceinline__ void sincos_rev(float ang, float& c, float& s) {
    const double t = (double)ang * 0.15915494309189535; const float f = (float)(t - __builtin_rint(t));
    s = __builtin_amdgcn_sinf(f); c = __builtin_amdgcn_cosf(f);
}

__device__ __forceinline__ void p0_prologue(const Args& A, LAS unsigned char* lds, int vcu, int G, int wave, int lane, int tid) {
    unsigned char* ws = A.ws;
    LAS float* scr = (LAS float*)(lds + RING_OFF + wave * 16384);
    const int gw = vcu * NWAVES + wave, NGW = G * NWAVES;
    bf16* WinA = (bf16*)(ws + WS_WINA); bf16* WoutA = (bf16*)(ws + WS_WOUTA); bf16* Wkvq = (bf16*)(ws + WS_WKVQ); bf16* W3 = (bf16*)(ws + WS_W3); bf16* WoutB = (bf16*)(ws + WS_WOUTB);
    constexpr int I_INA = 16 * 192, I_OUTA = 32 * 32, I_KV = 16 * 64, I_INB = 16 * 64, I_OUTB = 16 * 32;
    constexpr int NITEMS = 2 * I_INA + 2 * I_OUTA + I_KV + 2 * I_INB + 2 * I_OUTB;
    for (int it = gw; it < NITEMS; it += NGW) {
        int r = it;
        if (r < 2 * I_INA) { const int l = r / I_INA; r -= l * I_INA;
            transpose_item<1>(A.w_in_a + (size_t)l * 1024 * 6144, 6144, 0, 6144, 1024, A.pre_norm + l * 1024, WinA + (size_t)l * 6144 * 1024, 0, 2048, scr, r, lane); continue; }
        r -= 2 * I_INA;
        if (r < 2 * I_OUTA) { const int l = r / I_OUTA; r -= l * I_OUTA;
            transpose_item<0>(A.w_out_a + (size_t)l * 2048 * 1024, 1024, 0, 1024, 2048, nullptr, WoutA + (size_t)l * 1024 * 2048, 0, 0, scr, r, lane); continue; }
        r -= 2 * I_OUTA;
        if (r < I_KV) { transpose_item<2>(A.w_kv, 2048, 0, 2048, 1024, A.kv_norm, Wkvq, 0, 1024, scr, r, lane); continue; }
        r -= I_KV;
        if (r < I_INB) { transpose_item<2>(A.w_in_b, 2048, 0, 2048, 1024, A.pre_norm + 2 * 1024, Wkvq, 2048, 1024, scr, r, lane); continue; }
        r -= I_INB;
        if (r < I_INB) { transpose_item<2>(A.w_in_b + (size_t)1024 * 2048, 2048, 0, 2048, 1024, A.pre_norm + 3 * 1024, W3, 0, 1024, scr, r, lane); continue; }
        r -= I_INB;
        { const int l = r / I_OUTB; r -= l * I_OUTB;
          transpose_item<0>(A.w_out_b + (size_t)l * 1024 * 1024, 1024, 0, 1024, 1024, nullptr, WoutB + (size_t)l * 1024 * 1024, 0, 0, scr, r, lane); }
    }
    { float* cs128 = (float*)(ws + WS_CS128); float* cs64 = (float*)(ws + WS_CS64); const int gt = vcu * (NWAVES * 64) + tid, NGT = G * NWAVES * 64;
      for (int e = gt; e < 8192 * 64; e += NGT) { const int pos = e >> 6, i = e & 63; const float inv = powf(10000.0f, -(float)i / 64.0f); float c, s; sincos_rev((float)pos * inv, c, s); *(float2*)(cs128 + 2 * (size_t)e) = make_float2(c, s); }
      for (int e = gt; e < 8192 * 32; e += NGT) { const int pos = e >> 5, i = e & 31; const float inv = powf(10000.0f, -(float)i / 32.0f); float c, s; sincos_rev((float)pos * inv, c, s); *(float2*)(cs64 + 2 * (size_t)e) = make_float2(c, s); }
      if (gt < 8) { float* misc = (float*)(ws + WS_MISC); misc[gt] = log1pf(-exp2f(-5.0f - (float)gt)) * 1.4426950408889634f; }
      if (vcu == 0 && wave == 1) {
          float* misc = (float*)(ws + WS_MISC);
          for (int j = 0; j < 2; ++j) { const float a = wave_sum(A.lam_q1[j * 64 + lane] * A.lam_k1[j * 64 + lane]), b2 = wave_sum(A.lam_q2[j * 64 + lane] * A.lam_k2[j * 64 + lane]);
              if (lane == 0) misc[16 + j] = expf(a) - expf(b2) + (j == 0 ? LAMBDA_INIT2 : LAMBDA_INIT3); } } }
    for (int m = gw; m < M; m += NGW) row_to_xn(A.x + (size_t)m * DM, (bf16*)(ws + WS_XN) + (size_t)m * DM, lane);
}

__device__ __forceinline__ void norm_phase(const float* Y, const float* base, const float* gpost, float* out, bf16* XN, bool write_xn, int gw, int NGW, int lane) {
    f32x4 gp[4];
#pragma unroll
    for (int j = 0; j < 4; ++j) gp[j] = ((const f32x4*)gpost)[lane + 64 * j];
    for (int m = gw; m < M; m += NGW) {
        const GAS f32x4* yr = (const GAS f32x4*)(Y + (size_t)m * DM) + lane; const GAS f32x4* br = (const GAS f32x4*)(base + (size_t)m * DM) + lane;
        f32x4 y[4], xb[4]; float s = 0.f;
#pragma unroll
        for (int j = 0; j < 4; ++j) { y[j] = yr[64 * j]; xb[j] = br[64 * j]; s += (y[j].x * y[j].x + y[j].y * y[j].y) + (y[j].z * y[j].z + y[j].w * y[j].w); }
        const float rstd = 1.f / sqrtf(wave_sum(s) * (1.f / DM) + EPS); float s2 = 0.f;
        GAS f32x4* orow = (GAS f32x4*)(out + (size_t)m * DM) + lane;
#pragma unroll
        for (int j = 0; j < 4; ++j) { xb[j] = xb[j] + y[j] * rstd * gp[j]; orow[64 * j] = xb[j]; s2 += (xb[j].x * xb[j].x + xb[j].y * xb[j].y) + (xb[j].z * xb[j].z + xb[j].w * xb[j].w); }
        if (write_xn) { const float r2 = 1.f / sqrtf(wave_sum(s2) * (1.f / DM) + EPS); GAS unsigned long long* o8 = (GAS unsigned long long*)(XN + (size_t)m * DM) + lane;
#pragma unroll
            for (int j = 0; j < 4; ++j) o8[64 * j] = (unsigned long long)pkbf(xb[j].x * r2, xb[j].y * r2) | ((unsigned long long)pkbf(xb[j].z * r2, xb[j].w * r2) << 32); }
    }
}

__device__ __forceinline__ void combine_phase(const bf16* O0, bf16* O1, const bf16* Gt, const float* gsub, float lam, float oml, int gw, int NGW, int lane) {
    float gs[16];
#pragma unroll
    for (int i = 0; i < 16; ++i) gs[i] = gsub[((lane & 7) * 16 + i)] * oml;
    for (int m = gw; m < M; m += NGW) {
        const size_t off = (size_t)m * DM + lane * 16;
        const v4u a0 = *(const GAS v4u*)(O0 + off), a1 = *(const GAS v4u*)(O0 + off + 8), b0 = *(const GAS v4u*)(O1 + off), b1 = *(const GAS v4u*)(O1 + off + 8), g0 = *(const GAS v4u*)(Gt + off), g1 = *(const GAS v4u*)(Gt + off + 8);
        float d[16], gg[16];
        const unsigned aw[8] = {a0.x, a0.y, a0.z, a0.w, a1.x, a1.y, a1.z, a1.w}, bw[8] = {b0.x, b0.y, b0.z, b0.w, b1.x, b1.y, b1.z, b1.w}, gw8[8] = {g0.x, g0.y, g0.z, g0.w, g1.x, g1.y, g1.z, g1.w};
        float ss = 0.f;
#pragma unroll
        for (int i = 0; i < 8; ++i) { d[2 * i] = pg8::bflo(aw[i]) - lam * pg8::bflo(bw[i]); d[2 * i + 1] = pg8::bfhi(aw[i]) - lam * pg8::bfhi(bw[i]); gg[2 * i] = pg8::bflo(gw8[i]); gg[2 * i + 1] = pg8::bfhi(gw8[i]);
            ss += d[2 * i] * d[2 * i] + d[2 * i + 1] * d[2 * i + 1]; }
        ss += __shfl_xor(ss, 1); ss += __shfl_xor(ss, 2); ss += __shfl_xor(ss, 4);
        const float rstd = 1.f / sqrtf(ss * (1.f / 128.f) + EPS);
        unsigned o[8];
#pragma unroll
        for (int i = 0; i < 8; ++i) o[i] = pkbf(d[2 * i] * rstd * gs[2 * i] * gg[2 * i], d[2 * i + 1] * rstd * gs[2 * i + 1] * gg[2 * i + 1]);
        *(GAS v4u*)(O1 + off) = (v4u){o[0], o[1], o[2], o[3]}; *(GAS v4u*)(O1 + off + 8) = (v4u){o[4], o[5], o[6], o[7]};
    }
}

constexpr int N_PHASES = 23;
#define PH_ON(k) (SEL < 0 || SEL == (k))
template <int SEL> __global__ void __launch_bounds__(NWAVES * 64, 2) mk_fwd(Args A) {
    extern __shared__ __attribute__((aligned(16))) unsigned char lds_raw[];
    LAS unsigned char* lds = (LAS unsigned char*)lds_raw;
    const int tid = threadIdx.x, lane = tid & 63, wave = __builtin_amdgcn_readfirstlane(tid >> 6);
    const int G = gridDim.x, bx = blockIdx.x, vcu = (G % 8 == 0) ? (bx % 8) * (G / 8) + bx / 8 : bx;
    const int gw = vcu * NWAVES + wave, NGW = G * NWAVES;
    gu32* ctl = (gu32*)(A.ws + WS_CTL);
    for (int u = tid; u < (LDS_BYTES - LDSCTL_OFF) / 4; u += NWAVES * 64) ((LAS unsigned*)(lds + LDSCTL_OFF))[u] = 0u;
    __syncthreads();
    XcdBarrier bar; bar.bar = (unsigned*)(ctl + CW_BAR); bar.x = 0; bar.st = nullptr;
    if (A.use_bar) bar = xcd_barrier_post((unsigned*)(ctl + CW_BAR), (volatile LAS unsigned*)(lds + MISC_OFF) + 8);

#define WSP(T, off) ((T*)(A.ws + (off)))
#define PH_BEGIN(k) if (A.ph_lo <= (k) && (k) < A.ph_hi) {
#define PH_END(k) if (A.use_bar && (k) + 1 < A.ph_hi) xcd_barrier(bar); }
    const size_t MB1 = (size_t)M * 1024;
    PH_BEGIN(0) if (PH_ON(0)) p0_prologue(A, lds, vcu, G, wave, lane, tid); PH_END(0)
#pragma unroll 1
    for (int l = 0; l < 2; ++l) {
        const int pb = 1 + 6 * l;
        PH_BEGIN(pb + 0) if (PH_ON(1)) { pg8::Gemm g{WSP(bf16, WS_XN), WSP(bf16, WS_WINA) + (size_t)l * 6144 * 1024, M, 4096, 1024}; pg8::StaticOrder S; S.init(M, 4096, G, bx);
            pg8::EpiRet E{WSP(bf16, WS_R), WSP(bf16, WS_R) + MB1, WSP(bf16, WS_R) + 2 * MB1, WSP(float, WS_CS128), WSP(float, WS_MISC)};
            pg8::gemm_phase<pg8::EpiRet, pg8::StaticOrder, true, true>(lds + RING_OFF, g, S, E); } PH_END(pb + 0)
        PH_BEGIN(pb + 1) if (PH_ON(2)) { ret::Bufs B{WSP(bf16, WS_R), WSP(bf16, WS_R) + MB1, WSP(bf16, WS_R) + 2 * MB1, WSP(float, WS_L), WSP(float, WS_MISC)};
            for (int u = vcu; u < 256; u += G) if ((u & 15) != 15) ret::r1_unit(lds + RING_OFF, B, u); } PH_END(pb + 1)
        PH_BEGIN(pb + 2) if (PH_ON(3)) { ret::Bufs B{WSP(bf16, WS_R), WSP(bf16, WS_R) + MB1, WSP(bf16, WS_R) + 2 * MB1, WSP(float, WS_L), WSP(float, WS_MISC)};
            for (int u = vcu; u < 256; u += G) ret::r3_unit(lds + RING_OFF, B, u); } PH_END(pb + 2)
        PH_BEGIN(pb + 3) if (PH_ON(4)) { pg8::Gemm g{WSP(bf16, WS_XN), WSP(bf16, WS_WINA) + (size_t)l * 6144 * 1024 + (size_t)4096 * 1024, M, 2048, 1024}; pg8::StaticOrder S; S.init(M, 2048, G, bx);
            pg8::EpiGate E{WSP(bf16, WS_R) + 2 * MB1};
            pg8::gemm_phase<pg8::EpiGate, pg8::StaticOrder, true, true>(lds + RING_OFF, g, S, E); } PH_END(pb + 3)
        PH_BEGIN(pb + 4) if (PH_ON(5)) { pg8::Gemm g{WSP(bf16, WS_R) + 2 * MB1, WSP(bf16, WS_WOUTA) + (size_t)l * 1024 * 2048, M, 1024, 2048}; pg8::StaticOrder S; S.init(M, 1024, G, bx);
            pg8::EpiY E{WSP(float, WS_R), 1024};
            pg8::gemm_phase<pg8::EpiY, pg8::StaticOrder, true, true>(lds + RING_OFF, g, S, E); } PH_END(pb + 4)
        PH_BEGIN(pb + 5) if (PH_ON(6)) norm_phase(WSP(float, WS_R), l == 0 ? A.x : A.out, A.post_norm + l * 1024, A.out, WSP(bf16, WS_XN), true, gw, NGW, lane); PH_END(pb + 5)
    }
#pragma unroll 1
    for (int j = 0; j < 2; ++j) {
        const int pb = 13 + 5 * j;
        PH_BEGIN(pb + 0) if (PH_ON(7)) { pg8::Gemm g{WSP(bf16, WS_XN), j == 0 ? WSP(bf16, WS_WKVQ) : WSP(bf16, WS_W3), M, j == 0 ? 4096 : 2048, 1024}; pg8::StaticOrder S; S.init(M, g.N, G, bx);
            pg8::EpiDiff E{WSP(bf16, WS_R), WSP(bf16, WS_R) + MB1, WSP(bf16, WS_R) + 2 * MB1, WSP(bf16, WS_R) + 3 * MB1, WSP(float, WS_CS64), j == 0 ? 0 : 8, C2};
            pg8::gemm_phase<pg8::EpiDiff, pg8::StaticOrder, true, true>(lds + RING_OFF, g, S, E); } PH_END(pb + 0)
        PH_BEGIN(pb + 1) if (PH_ON(8)) { const attn_body::AttnTensors AT{WSP(const attn_body::bf16, WS_R) + 2 * MB1, WSP(const attn_body::bf16, WS_R), WSP(const attn_body::bf16, WS_R) + MB1, WSP(attn_body::bf16, WS_XN), WSP(attn_body::bf16, WS_L)};
            const attn_body::StaticOrder S(G, bx);
            attn_body::attn_phase<attn_body::StaticOrder>((char*)lds_raw + RING_OFF, AT, S); } PH_END(pb + 1)
        PH_BEGIN(pb + 2) if (PH_ON(9)) combine_phase(WSP(bf16, WS_XN), WSP(bf16, WS_L), WSP(bf16, WS_R) + 3 * MB1, A.sub_norm_b + j * 128, WSP(float, WS_MISC)[16 + j], 1.0f - (j == 0 ? LAMBDA_INIT2 : LAMBDA_INIT3), gw, NGW, lane); PH_END(pb + 2)
        PH_BEGIN(pb + 3) if (PH_ON(10)) { pg8::Gemm g{WSP(bf16, WS_L), WSP(bf16, WS_WOUTB) + (size_t)j * 1024 * 1024, M, 1024, 1024}; pg8::StaticOrder S; S.init(M, 1024, G, bx);
            pg8::EpiY E{WSP(float, WS_R + 64 * MiB), 1024};
            pg8::gemm_phase<pg8::EpiY, pg8::StaticOrder, true, true>(lds + RING_OFF, g, S, E); } PH_END(pb + 3)
        PH_BEGIN(pb + 4) if (PH_ON(6)) norm_phase(WSP(float, WS_R + 64 * MiB), A.out, A.post_norm + (2 + j) * 1024, A.out, WSP(bf16, WS_XN), j == 0, gw, NGW, lane); PH_END(pb + 4)
    }
}

#ifndef MK_FUSED
#define MK_FUSED 0
#endif
typedef void (*kern_t)(Args);
static int phase_sel(int ph) {
    if (ph == 0) return 0;
    if (ph <= 12) return 1 + (ph - 1) % 6;
    const int k = (ph - 13) % 5; return k == 4 ? 6 : 7 + k;
}
static kern_t sel_kernel(int sel) {
    switch (sel) { case 0: return mk_fwd<0>; case 1: return mk_fwd<1>; case 2: return mk_fwd<2>; case 3: return mk_fwd<3>; case 4: return mk_fwd<4>; case 5: return mk_fwd<5>;
                   case 6: return mk_fwd<6>; case 7: return mk_fwd<7>; case 8: return mk_fwd<8>; case 9: return mk_fwd<9>; default: return mk_fwd<10>; }
}
extern "C" void kernel_launch(void* const* d_in, const int* in_sizes, int n_in, void* d_out, int out_size, void* d_ws, size_t ws_size, hipStream_t stream) {
    static int grid = 0;
    if (grid == 0) {
        if (n_in != 14 || out_size != M * DM || ws_size < WS_END) { fprintf(stderr, "kernel_launch: unexpected shapes (n_in %d out %d ws %zu)\n", n_in, out_size, ws_size); grid = -1; return; }
        int dev = 0, cus = 0;
        if (hipGetDevice(&dev) != hipSuccess || hipDeviceGetAttribute(&cus, hipDeviceAttributeMultiprocessorCount, dev) != hipSuccess) { grid = -1; return; }
#if MK_FUSED
        if (hipFuncSetAttribute((const void*)mk_fwd<-1>, hipFuncAttributeMaxDynamicSharedMemorySize, LDS_BYTES) != hipSuccess) { fprintf(stderr, "kernel_launch: hipFuncSetAttribute failed\n"); grid = -1; return; }
#else
        for (int k = 0; k <= 10; ++k) if (hipFuncSetAttribute((const void*)sel_kernel(k), hipFuncAttributeMaxDynamicSharedMemorySize, LDS_BYTES) != hipSuccess) { fprintf(stderr, "kernel_launch: hipFuncSetAttribute failed\n"); grid = -1; return; }
#endif
        (void)hipGetLastError();
        grid = cus;
    }
    if (grid < 0) return;
    (void)hipMemsetAsync((char*)d_ws + WS_CTL, 0, CTL_ZERO_BYTES, stream);
    Args a{};
    a.x = (const float*)d_in[0]; a.pre_norm = (const float*)d_in[1]; a.post_norm = (const float*)d_in[2]; a.w_in_a = (const float*)d_in[3]; a.w_out_a = (const float*)d_in[4];
    a.kv_norm = (const float*)d_in[5]; a.w_kv = (const float*)d_in[6]; a.w_in_b = (const float*)d_in[7]; a.lam_q1 = (const float*)d_in[8]; a.lam_k1 = (const float*)d_in[9];
    a.lam_q2 = (const float*)d_in[10]; a.lam_k2 = (const float*)d_in[11]; a.sub_norm_b = (const float*)d_in[12]; a.w_out_b = (const float*)d_in[13];
    a.out = (float*)d_out; a.ws = (unsigned char*)d_ws;
#if MK_FUSED
    a.ph_lo = 0; a.ph_hi = N_PHASES; a.use_bar = 1;
    hipLaunchKernelGGL(mk_fwd<-1>, dim3(grid), dim3(NWAVES * 64), LDS_BYTES, stream, a);
#else
    for (int ph = 0; ph < N_PHASES; ++ph) { a.ph_lo = ph; a.ph_hi = ph + 1; a.use_bar = 0; hipLaunchKernelGGL(sel_kernel(phase_sel(ph)), dim3(grid), dim3(NWAVES * 64), LDS_BYTES, stream, a); }
#endif
}
```

```cpp
#include <hip/hip_runtime.h>
#include <hip/hip_bf16.h>
#include <cstdio>
#include <cstdint>
#include <cmath>
namespace pg8 {
#define PG8_LAS __attribute__((address_space(3)))
typedef unsigned short bf16_t;
typedef short bf16x8 __attribute__((ext_vector_type(8)));
typedef float f32x4 __attribute__((ext_vector_type(4)));
typedef unsigned u32x4 __attribute__((ext_vector_type(4)));
constexpr int BM = 256, BK = 64, HALF = 128, HTB = HALF * BK * 2  , STAGE_BYTES = 8 * HTB, NXCD = 8, WGM = 8;

__host__ __device__ __forceinline__ int lds_byte(int r, int c) { const int st = (r >> 4) * 2 + (c >> 5), rr = r & 15, cc = c & 31, ob = rr * 64 + cc * 2; return st * 1024 + (ob ^ (((ob >> 9) & 1) << 5)); }
__host__ __device__ __forceinline__ void stage_rc(int b, int& R, int& C) { const int st = b / 1024, sb = b % 1024, swz = sb ^ (((sb >> 9) & 1) << 5); R = (st >> 1) * 16 + swz / 64; C = (st & 1) * 32 + (swz % 64) / 2; }
__host__ __device__ __forceinline__ int perm32(int rho) { const int n = rho >> 4, i = rho & 15; return 8 * (i >> 2) + 4 * n + (i & 3); }

struct Unit { int pm, pn; };
struct Gemm { const bf16_t* A; const bf16_t* Bt; int M, N, K; };

struct StaticOrder {
    int nM, nN, nwg, G, c;
    __host__ __device__ void init(int M, int N, int G_, int c_) { nM = M / BM; nN = N / BM; nwg = nM * nN; G = G_; c = c_; }
    __host__ __device__ bool next(int i, Unit& u) const {
        const long L = (long)i * G + c; if (L >= nwg) return false;
        int wgid = (int)L; { const int q = nwg / NXCD, r = nwg % NXCD, xcd = wgid % NXCD, off = wgid / NXCD; wgid = (xcd < r ? xcd * (q + 1) : r * (q + 1) + (xcd - r) * q) + off; }
        const int nig = WGM * nN, gid = wgid / nig, fm = gid * WGM, gsz = (nM - fm) < WGM ? (nM - fm) : WGM;
        u.pm = fm + ((wgid % nig) % gsz); u.pn = (wgid % nig) / gsz; return true;
    }
    __device__ __forceinline__ void a_ready(const Unit&) const {}
    __device__ __forceinline__ void done(const Unit&) const {}
};

__device__ __forceinline__ unsigned cvt_pk_bf16(float lo, float hi) { unsigned r; asm volatile("v_cvt_pk_bf16_f32 %0, %1, %2" : "=v"(r) : "v"(lo), "v"(hi)); return r; }
typedef float f32x2 __attribute__((ext_vector_type(2)));
__device__ __forceinline__ f32x2 gelu_pk(f32x2 v) {
    const f32x2 av = __builtin_elementwise_abs(v), d = av * 0.2316418882f + 1.0f;
    f32x2 t; t.x = __builtin_amdgcn_rcpf(d.x); t.y = __builtin_amdgcn_rcpf(d.y);
    f32x2 q = t * 0.5307027145f + (-0.7265760135f); q = q * t + 0.7107068705f; q = q * t + (-0.142248368f); q = q * t + 0.127414796f; q = q * t;
    const f32x2 s = (v * v) * (-0.72134752044f);
    f32x2 e; e.x = __builtin_amdgcn_exp2f(s.x); e.y = __builtin_amdgcn_exp2f(s.y);
    const f32x2 m = v * (q * e), r = v - m;
    f32x2 o; o.x = v.x < 0.f ? m.x : r.x; o.y = v.y < 0.f ? m.y : r.y; return o;
}

template <int ACT  > struct EpiBf16 {
    static constexpr bool PERM = true, AFTER_DRAIN = false; static_assert(ACT == 0 || ACT == 1, "EpiBf16: ACT is 0 (none) or 1 (gelu_pk)");
    bf16_t* O; int ldc; const float* bias; int split_cols; size_t split_stride; float scale0;
    __device__ __forceinline__ void operator()(const f32x4 (&acc)[2][2][4][2], const Unit& u, int wr, int wc, int fr, int fq) const {
        const int row0 = u.pm * BM + wr * 64 + fr; int colt = u.pn * BM; bf16_t* base = O;
        float sc = 1.f; if (split_cols) { const int t = colt / split_cols; base += (size_t)t * split_stride; colt -= t * split_cols; if (t == 0) sc = scale0; }
        const int col0 = colt + wc * 32 + 8 * fq, bcol0 = u.pn * BM + wc * 32 + 8 * fq;
        f32x4 bv[2][2];
#pragma unroll
        for (int bj = 0; bj < 2; ++bj)
#pragma unroll
            for (int n = 0; n < 2; ++n) bv[bj][n] = bias ? *(const f32x4*)(bias + bcol0 + bj * HALF + 4 * n) : (f32x4){0.f, 0.f, 0.f, 0.f};
#pragma unroll
        for (int ai = 0; ai < 2; ++ai)
#pragma unroll
            for (int m = 0; m < 4; ++m) { bf16_t* rowp = base + (size_t)(row0 + ai * HALF + m * 16) * ldc + col0;
#pragma unroll
                for (int bj = 0; bj < 2; ++bj) { f32x4 v0 = acc[ai][bj][m][0] + bv[bj][0], v1 = acc[ai][bj][m][1] + bv[bj][1];
                    if (ACT == 1) { f32x2 a = gelu_pk((f32x2){v0[0], v0[1]}), b = gelu_pk((f32x2){v0[2], v0[3]}), c = gelu_pk((f32x2){v1[0], v1[1]}), d = gelu_pk((f32x2){v1[2], v1[3]});
                        v0 = (f32x4){a.x, a.y, b.x, b.y}; v1 = (f32x4){c.x, c.y, d.x, d.y}; }
                    v0 = v0 * sc; v1 = v1 * sc; u32x4 w; w.x = cvt_pk_bf16(v0[0], v0[1]); w.y = cvt_pk_bf16(v0[2], v0[3]); w.z = cvt_pk_bf16(v1[0], v1[1]); w.w = cvt_pk_bf16(v1[2], v1[3]);
                    *(u32x4*)(rowp + bj * HALF) = w; } }
    }
};
typedef __bf16 bf16x2_t __attribute__((ext_vector_type(2)));
__device__ __forceinline__ unsigned pkbf(float lo, float hi) { f32x2 v = {lo, hi}; bf16x2_t b = __builtin_convertvector(v, bf16x2_t); return __builtin_bit_cast(unsigned, b); }
__device__ __forceinline__ float bflo(unsigned u) { return __builtin_bit_cast(float, u << 16); }
__device__ __forceinline__ float bfhi(unsigned u) { return __builtin_bit_cast(float, u & 0xffff0000u); }
__device__ __forceinline__ float silu_f(float x) { return x * __builtin_amdgcn_rcpf(1.0f + __builtin_amdgcn_exp2f(-1.4426950408889634f * x)); }
__device__ __forceinline__ void rope8(f32x4& v0, f32x4& v1, const float* cs, float sc) {
    const f32x4 t0 = *(const f32x4*)cs, t1 = *(const f32x4*)(cs + 4);
    f32x4 o0, o1;
    o0[0] = (v0[0] * t0[0] - v0[1] * t0[1]) * sc; o0[1] = (v0[0] * t0[1] + v0[1] * t0[0]) * sc;
    o0[2] = (v0[2] * t0[2] - v0[3] * t0[3]) * sc; o0[3] = (v0[2] * t0[3] + v0[3] * t0[2]) * sc;
    o1[0] = (v1[0] * t1[0] - v1[1] * t1[1]) * sc; o1[1] = (v1[0] * t1[1] + v1[1] * t1[0]) * sc;
    o1[2] = (v1[2] * t1[2] - v1[3] * t1[3]) * sc; o1[3] = (v1[2] * t1[3] + v1[3] * t1[2]) * sc;
    v0 = o0; v1 = o1;
}
__device__ __forceinline__ u32x4 pack8(const f32x4& v0, const f32x4& v1) { u32x4 w; w.x = pkbf(v0[0], v0[1]); w.y = pkbf(v0[2], v0[3]); w.z = pkbf(v1[0], v1[1]); w.w = pkbf(v1[2], v1[3]); return w; }

struct EpiRet {
    static constexpr bool PERM = true, AFTER_DRAIN = false;
    bf16_t* Q; bf16_t* KD; bf16_t* V; const float* cs128; const float* lgtab;
    __device__ __forceinline__ void operator()(const f32x4 (&acc)[2][2][4][2], const Unit& u, int wr, int wc, int fr, int fq) const {
        const int row0 = u.pm * BM + wr * 64 + fr, pb = wc * 32 + 8 * fq;
        if (u.pn < 8) {
            const bool isk = u.pn >= 4; bf16_t* base = (isk ? KD : Q) + (u.pn & 3) * 256 + pb;
            float lg[2] = {0.f, 0.f}; if (isk) { lg[0] = lgtab[(u.pn - 4) * 2]; lg[1] = lgtab[(u.pn - 4) * 2 + 1]; }
#pragma unroll
            for (int ai = 0; ai < 2; ++ai)
#pragma unroll
                for (int m = 0; m < 4; ++m) { const int row = row0 + ai * HALF + m * 16, pos = row & 8191; const float* cs = cs128 + ((size_t)pos * 64 + (pb >> 1)) * 2;
#pragma unroll
                    for (int bj = 0; bj < 2; ++bj) { float sc = 1.f; if (isk) sc = 0.08838834764831845f * __builtin_amdgcn_exp2f((float)(63 - (pos & 63)) * lg[bj]);
                        f32x4 v0 = acc[ai][bj][m][0], v1 = acc[ai][bj][m][1]; rope8(v0, v1, cs, sc);
                        *(u32x4*)(base + (size_t)row * 1024 + bj * HALF) = pack8(v0, v1); }
                    asm volatile("" ::: "memory"); }
        } else {
            bf16_t* base = V + (u.pn - 8) * 256 + pb;
#pragma unroll
            for (int ai = 0; ai < 2; ++ai)
#pragma unroll
                for (int m = 0; m < 4; ++m) { const int row = row0 + ai * HALF + m * 16;
#pragma unroll
                    for (int bj = 0; bj < 2; ++bj) *(u32x4*)(base + (size_t)row * 2048 + bj * HALF) = pack8(acc[ai][bj][m][0], acc[ai][bj][m][1]); }
        }
    }
};
struct EpiGate {
    static constexpr bool PERM = true, AFTER_DRAIN = false;
    bf16_t* On;
    __device__ __forceinline__ void operator()(const f32x4 (&acc)[2][2][4][2], const Unit& u, int wr, int wc, int fr, int fq) const {
        const int row0 = u.pm * BM + wr * 64 + fr; bf16_t* base = On + u.pn * 256 + wc * 32 + 8 * fq;
#pragma unroll
        for (int ai = 0; ai < 2; ++ai)
#pragma unroll
            for (int m = 0; m < 4; ++m) { const int row = row0 + ai * HALF + m * 16;
#pragma unroll
                for (int bj = 0; bj < 2; ++bj) { u32x4* p = (u32x4*)(base + (size_t)row * 2048 + bj * HALF); const u32x4 o = *p; const f32x4 g0 = acc[ai][bj][m][0], g1 = acc[ai][bj][m][1];
                    f32x4 v0, v1; v0[0] = bflo(o.x) * silu_f(g0[0]); v0[1] = bfhi(o.x) * silu_f(g0[1]); v0[2] = bflo(o.y) * silu_f(g0[2]); v0[3] = bfhi(o.y) * silu_f(g0[3]);
                    v1[0] = bflo(o.z) * silu_f(g1[0]); v1[1] = bfhi(o.z) * silu_f(g1[1]); v1[2] = bflo(o.w) * silu_f(g1[2]); v1[3] = bfhi(o.w) * silu_f(g1[3]);
                    *p = pack8(v0, v1); }
                asm volatile("" ::: "memory"); }
    }
};
struct EpiY {
    static constexpr bool PERM = false, AFTER_DRAIN = false;
    float* Y; int ldc;
    __device__ __forceinline__ void operator()(const f32x4 (&acc)[2][2][4][2], const Unit& u, int wr, int wc, int fr, int fq) const {
        const int row0 = u.pm * BM + wr * 64 + fr; float* base = Y + u.pn * 256 + wc * 32 + 4 * fq;
#pragma unroll
        for (int ai = 0; ai < 2; ++ai)
#pragma unroll
            for (int m = 0; m < 4; ++m) { float* rp = base + (size_t)(row0 + ai * HALF + m * 16) * ldc;
#pragma unroll
                for (int bj = 0; bj < 2; ++bj)
#pragma unroll
                    for (int n = 0; n < 2; ++n) *(f32x4*)(rp + bj * HALF + n * 16) = acc[ai][bj][m][n]; }
    }
};
struct EpiDiff {
    static constexpr bool PERM = true, AFTER_DRAIN = false;
    bf16_t* KS; bf16_t* VS; bf16_t* Q2; bf16_t* G; const float* cs64; int pn_off; float qscale;
    __device__ __forceinline__ void operator()(const f32x4 (&acc)[2][2][4][2], const Unit& u, int wr, int wc, int fr, int fq) const {
        const int row0 = u.pm * BM + wr * 64 + fr, pb = wc * 32 + 8 * fq, t = u.pn + pn_off, ty = t >> 2;
        bf16_t* base = (ty == 0 ? KS : ty == 1 ? VS : ty == 2 ? Q2 : G) + (t & 3) * 256 + pb;
        const float sc = (ty == 2) ? qscale : 1.f;
#pragma unroll
        for (int ai = 0; ai < 2; ++ai)
#pragma unroll
            for (int m = 0; m < 4; ++m) { const int row = row0 + ai * HALF + m * 16, pos = row & 8191; const float* cs = cs64 + ((size_t)pos * 32 + ((pb & 63) >> 1)) * 2;
#pragma unroll
                for (int bj = 0; bj < 2; ++bj) { f32x4 v0 = acc[ai][bj][m][0], v1 = acc[ai][bj][m][1];
                    if (ty == 0 || ty == 2) rope8(v0, v1, cs, sc);
                    else if (ty == 3) {
#pragma unroll
                        for (int e = 0; e < 4; ++e) { v0[e] = silu_f(v0[e]); v1[e] = silu_f(v1[e]); } }
                    *(u32x4*)(base + (size_t)row * 1024 + bj * HALF) = pack8(v0, v1); }
                asm volatile("" ::: "memory"); }
    }
};
template <class Epi, class Sched, bool ALIGN_EPI = false, bool SP2 = false>
__device__ __forceinline__ void gemm_phase(PG8_LAS unsigned char* lds, const Gemm g, const Sched& S, const Epi& E) {
    int tid_o = threadIdx.x; asm volatile("" : "+v"(tid_o));
    const int tid = tid_o, wid = __builtin_amdgcn_readfirstlane(tid >> 6), lane = tid & 63, wr = wid >> 2, wc = wid & 3, fr = lane & 15, fq = lane >> 4;
    const int K = g.K, nt = K / BK;
    unsigned voffA[2], voffB[2];
#pragma unroll
    for (int i = 0; i < 2; ++i) { int R, C; stage_rc(tid * 16 + i * 8192, R, C); const int Rb = Epi::PERM ? ((R & ~31) + perm32(R & 31)) : R;
        voffA[i] = (unsigned)(R * K + C) * 2u; voffB[i] = (unsigned)(Rb * K + C) * 2u; }
    const size_t kstep = (size_t)(BK * 2);
    const size_t hstep = (size_t)HALF * K * 2;
    const size_t tstep = 2 * hstep;
    const unsigned ldsw = (unsigned)wid * 1024u;
    const int aoff = lds_byte(wr * 64 + fr, fq * 8), boff = lds_byte(wc * 32 + fr, fq * 8);
#define PG8_SA(b, h) (((b) * 2 + (h)) * HTB)
#define PG8_SB(b, h) ((4 + (b) * 2 + (h)) * HTB)
#define PG8_STAGE(bufoff, gbase, voff) do { _Pragma("unroll") for (int _i = 0; _i < 2; ++_i) \
        __builtin_amdgcn_global_load_lds((const unsigned*)((const char*)(gbase) + (voff)[_i]), (PG8_LAS unsigned*)(lds + (bufoff) + ldsw + _i * 8192), 16, 0, 0); } while (0)
#define PG8_LDA(dst, b, h) do { _Pragma("unroll") for (int m = 0; m < 4; ++m) _Pragma("unroll") for (int k = 0; k < 2; ++k) dst[m][k] = *(const PG8_LAS bf16x8*)(lds + PG8_SA(b, h) + aoff + m * 2048 + k * 1024); } while (0)
#define PG8_LDB(dst, b, h) do { _Pragma("unroll") for (int n = 0; n < 2; ++n) _Pragma("unroll") for (int k = 0; k < 2; ++k) dst[n][k] = *(const PG8_LAS bf16x8*)(lds + PG8_SB(b, h) + boff + n * 2048 + k * 1024); } while (0)
#define PG8_MMA(ai, bj, At, Bt) do { __builtin_amdgcn_s_setprio(1); _Pragma("unroll") for (int m = 0; m < 4; ++m) _Pragma("unroll") for (int n = 0; n < 2; ++n) _Pragma("unroll") for (int k = 0; k < 2; ++k) \
        acc[ai][bj][m][n] = __builtin_amdgcn_mfma_f32_16x16x32_bf16(Bt[n][k], At[m][k], acc[ai][bj][m][n], 0, 0, 0); __builtin_amdgcn_s_setprio(0); } while (0)
#define PG8_WAIT_V(n) asm volatile("s_waitcnt vmcnt(" #n ")" ::: "memory")
#define PG8_WAIT_L(n) asm volatile("s_waitcnt lgkmcnt(" #n ")" ::: "memory")
#define PG8_BAR __builtin_amdgcn_s_barrier()
#define PG8_SCHED __builtin_amdgcn_sched_barrier(0)
    Unit cur, nxt; int ui = 0;
    if (!S.next(0, cur)) return;
    f32x4 acc[2][2][4][2];
#pragma unroll
    for (int a = 0; a < 2; ++a)
#pragma unroll
        for (int b = 0; b < 2; ++b)
#pragma unroll
            for (int m = 0; m < 4; ++m)
#pragma unroll
                for (int n = 0; n < 2; ++n) acc[a][b][m][n] = (f32x4){0.f, 0.f, 0.f, 0.f};
    bf16x8 At[4][2], B0[2][2], B1[2][2];
    const char* cA = (const char*)g.A + (size_t)cur.pm * tstep; const char* cB = (const char*)g.Bt + (size_t)cur.pn * tstep;
    S.a_ready(cur);
    if constexpr (SP2) {
        PG8_STAGE(PG8_SB(0, 0), cB, voffB); PG8_STAGE(PG8_SB(0, 1), cB + hstep, voffB); PG8_STAGE(PG8_SA(0, 0), cA, voffA); PG8_STAGE(PG8_SA(0, 1), cA + hstep, voffA);
        if (wr == 1) PG8_BAR;
        PG8_WAIT_V(2); PG8_BAR;
        PG8_STAGE(PG8_SB(1, 0), cB + kstep, voffB); PG8_STAGE(PG8_SA(1, 0), cA + kstep, voffA); PG8_STAGE(PG8_SB(1, 1), cB + hstep + kstep, voffB);
        PG8_WAIT_V(6); PG8_BAR;
    } else {
        PG8_STAGE(PG8_SB(0, 0), cB, voffB); PG8_STAGE(PG8_SA(0, 0), cA, voffA); PG8_STAGE(PG8_SB(0, 1), cB + hstep, voffB); PG8_STAGE(PG8_SA(0, 1), cA + hstep, voffA);
        if (wr == 1) PG8_BAR;
        PG8_WAIT_V(4); PG8_BAR;
        PG8_STAGE(PG8_SB(1, 0), cB + kstep, voffB); PG8_STAGE(PG8_SA(1, 0), cA + kstep, voffA); PG8_STAGE(PG8_SB(1, 1), cB + hstep + kstep, voffB);
        PG8_WAIT_V(6); PG8_BAR;
    }
    for (;;) {
        const bool has_next = S.next(ui + 1, nxt);
        const char* nA = has_next ? (const char*)g.A + (size_t)nxt.pm * tstep : cA; const char* nB = has_next ? (const char*)g.Bt + (size_t)nxt.pn * tstep : cB;
        for (int t = 0; t < nt; t += 2) {
            const bool last = (t == nt - 2);
            const char* a1 = cA + (size_t)(t + 1) * kstep;
            const char* a2 = last ? nA : cA + (size_t)(t + 2) * kstep; const char* b2 = last ? nB : cB + (size_t)(t + 2) * kstep;
            const char* a3 = a2 + kstep; const char* b3 = b2 + kstep;
            if (last && has_next) S.a_ready(nxt);
            if constexpr (SP2) {
            PG8_LDB(B0, 0, 0); PG8_LDB(B1, 0, 1); PG8_SCHED; PG8_LDA(At, 0, 0); PG8_STAGE(PG8_SA(1, 1), a1 + hstep, voffA);
            PG8_WAIT_V(8); PG8_WAIT_L(0); PG8_BAR; PG8_MMA(0, 0, At, B0); PG8_MMA(0, 1, At, B1); PG8_BAR; PG8_SCHED;
            PG8_LDA(At, 0, 1); PG8_STAGE(PG8_SB(0, 0), b2, voffB); PG8_STAGE(PG8_SB(0, 1), b2 + hstep, voffB); PG8_STAGE(PG8_SA(0, 0), a2, voffA);
            PG8_WAIT_V(8); PG8_WAIT_L(0); PG8_BAR; PG8_MMA(1, 0, At, B0); PG8_MMA(1, 1, At, B1); PG8_BAR; PG8_SCHED;
            PG8_LDB(B0, 1, 0); PG8_LDB(B1, 1, 1); PG8_SCHED; PG8_LDA(At, 1, 0); PG8_STAGE(PG8_SA(0, 1), a2 + hstep, voffA);
            PG8_WAIT_V(8); PG8_WAIT_L(0); PG8_BAR; PG8_MMA(0, 0, At, B0); PG8_MMA(0, 1, At, B1); PG8_BAR; PG8_SCHED;
            PG8_LDA(At, 1, 1); PG8_STAGE(PG8_SB(1, 0), b3, voffB); PG8_STAGE(PG8_SB(1, 1), b3 + hstep, voffB); PG8_STAGE(PG8_SA(1, 0), a3, voffA);
            PG8_WAIT_V(8); PG8_WAIT_L(0); PG8_BAR; PG8_MMA(1, 0, At, B0); PG8_MMA(1, 1, At, B1); PG8_BAR; PG8_SCHED;
            } else {
            PG8_LDB(B0, 0, 0); PG8_SCHED; PG8_LDA(At, 0, 0); PG8_STAGE(PG8_SA(1, 1), a1 + hstep, voffA);
            PG8_WAIT_L(8); PG8_BAR; PG8_WAIT_L(0); PG8_MMA(0, 0, At, B0); PG8_BAR; PG8_SCHED;
            PG8_LDB(B1, 0, 1); PG8_STAGE(PG8_SB(0, 0), b2, voffB);
            PG8_BAR; PG8_WAIT_L(0); PG8_MMA(0, 1, At, B1); PG8_BAR;
            PG8_LDA(At, 0, 1); PG8_STAGE(PG8_SA(0, 0), a2, voffA);
            PG8_BAR; PG8_WAIT_L(0); PG8_MMA(1, 0, At, B0); PG8_BAR; PG8_SCHED;
            PG8_STAGE(PG8_SB(0, 1), b2 + hstep, voffB);
            PG8_WAIT_V(6); PG8_BAR; PG8_MMA(1, 1, At, B1); PG8_BAR;
            PG8_LDB(B0, 1, 0); PG8_SCHED; PG8_LDA(At, 1, 0); PG8_STAGE(PG8_SA(0, 1), a2 + hstep, voffA);
            PG8_WAIT_L(8); PG8_BAR; PG8_WAIT_L(0); PG8_MMA(0, 0, At, B0); PG8_BAR; PG8_SCHED;
            PG8_LDB(B1, 1, 1); PG8_STAGE(PG8_SB(1, 0), b3, voffB);
            PG8_BAR; PG8_WAIT_L(0); PG8_MMA(0, 1, At, B1); PG8_BAR;
            PG8_LDA(At, 1, 1); PG8_STAGE(PG8_SA(1, 0), a3, voffA);
            PG8_BAR; PG8_WAIT_L(0); PG8_MMA(1, 0, At, B0); PG8_BAR; PG8_SCHED;
            PG8_STAGE(PG8_SB(1, 1), b3 + hstep, voffB);
            PG8_WAIT_V(6); PG8_BAR; PG8_MMA(1, 1, At, B1); PG8_BAR;
            }
        }
        if constexpr (ALIGN_EPI) { if (wr == 0) PG8_BAR; }
        if constexpr (!Epi::AFTER_DRAIN) { E(acc, cur, wr, wc, fr, fq); S.done(cur); }
        if (!has_next) break;
#pragma unroll
        for (int a = 0; a < 2; ++a)
#pragma unroll
            for (int b = 0; b < 2; ++b)
#pragma unroll
                for (int m = 0; m < 4; ++m)
#pragma unroll
                    for (int n = 0; n < 2; ++n) acc[a][b][m][n] = (f32x4){0.f, 0.f, 0.f, 0.f};
        cur = nxt; cA = nA; cB = nB; ++ui;
        if constexpr (ALIGN_EPI) { if (wr == 1) PG8_BAR; }
    }
    PG8_WAIT_V(0);
    if constexpr (!ALIGN_EPI) { if (wr == 0) PG8_BAR; }
    PG8_BAR;
    if constexpr (Epi::AFTER_DRAIN) { E.fused(acc, cur, wr, wc, fr, fq, lds, wid, lane); S.done(cur); }
#undef PG8_SA
#undef PG8_SB
#undef PG8_STAGE
#undef PG8_LDA
#undef PG8_LDB
#undef PG8_MMA
#undef PG8_WAIT_V
#undef PG8_WAIT_L
#undef PG8_BAR
#undef PG8_SCHED
}
}
namespace attn_body {
using bf16=__hip_bfloat16;
using bf16x8=__attribute__((ext_vector_type(8)))short;
using s16x4=__attribute__((ext_vector_type(4)))short;
using f32x16=__attribute__((ext_vector_type(16)))float;
using u32x4=__attribute__((ext_vector_type(4)))unsigned;
constexpr int BATCH=2,NHEAD=16,SEQ=8192,D=64,DM=NHEAD*D;
constexpr int NW=8,QBLK=32,QB=QBLK*NW,KVBLK=64,NQB=SEQ/QB;
constexpr int ATTN_PITCH=DM, ATTN_UNIT_ROWS=QB;
__device__ __forceinline__ int crow(int r,int hi){return (r&3)+8*(r>>2)+4*hi;}
#define SBAR() __builtin_amdgcn_sched_barrier(0)
__device__ __forceinline__ void cmask(f32x16&p0,f32x16&p1,int jb,int qrel,int hi){
  const float NEG=-INFINITY; (void)hi;
  if(jb>(qrel>>6)){
  #pragma unroll
  for(int r=0;r<16;++r){p0[r]=NEG;p1[r]=NEG;} }
}

constexpr int NSLOT=3, SLOTB=8192;
constexpr int LDS_K=0, LDS_V=NSLOT*SLOTB, LDS_WS=2*NSLOT*SLOTB, LDS_OST=LDS_WS+NW*64*4, LDS_BYTES=LDS_OST+NW*4096;
constexpr float C2=0.125f*1.4426950408889634f;
__device__ __forceinline__ void glds16(const void*gsrc,unsigned lds_dst){unsigned keep;
  asm volatile("s_mov_b32 %0, m0\n\ts_mov_b32 m0, %2\n\ts_nop 0\n\tglobal_load_lds_dwordx4 %1, off\n\ts_mov_b32 m0, %0":"=&s"(keep):"v"(gsrc),"s"(lds_dst):"memory");}
__device__ __forceinline__ float max3f(float a,float b,float c){float r;asm("v_max3_f32 %0, %1, %2, %3":"=v"(r):"v"(a),"v"(b),"v"(c));return r;}
__device__ __forceinline__ float max2f(float a,float b){float r;asm("v_max_f32_e32 %0, %1, %2":"=v"(r):"v"(a),"v"(b));return r;}
__device__ __forceinline__ float fadd_s(float a,float b){float r;asm("v_add_f32_e32 %0, %1, %2":"=v"(r):"v"(a),"v"(b));return r;}
__device__ __forceinline__ float fsub_s(float a,float b){float r;asm("v_sub_f32_e32 %0, %1, %2":"=v"(r):"v"(a),"v"(b));return r;}
typedef float f32x2_t __attribute__((ext_vector_type(2))); typedef __bf16 bf16x2_t __attribute__((ext_vector_type(2)));
__device__ __forceinline__ unsigned cvtpk_s(float lo,float hi){f32x2_t v={lo,hi};bf16x2_t b=__builtin_convertvector(v,bf16x2_t);return __builtin_bit_cast(unsigned,b);}
#define WAIT_BAR(N) asm volatile("s_waitcnt vmcnt(" #N ") lgkmcnt(0)\n\ts_barrier":::"memory")

__device__ __forceinline__ void qkt(f32x16&p0,f32x16&p1,const char*Kslot,const bf16x8*qr,const f32x16&negm,int r32,int hi){
  const char*kb=Kslot+hi*1024+r32*16;
  #pragma unroll
  for(int d0=0;d0<4;++d0){
    const bf16x8 b0=*reinterpret_cast<const bf16x8*>(kb+d0*2048);
    const bf16x8 b1=*reinterpret_cast<const bf16x8*>(kb+d0*2048+512);
    if(d0==0){p0=__builtin_amdgcn_mfma_f32_32x32x16_bf16(b0,qr[0],negm,0,0,0);p1=__builtin_amdgcn_mfma_f32_32x32x16_bf16(b1,qr[0],negm,0,0,0);}
    else{p0=__builtin_amdgcn_mfma_f32_32x32x16_bf16(b0,qr[d0],p0,0,0,0);p1=__builtin_amdgcn_mfma_f32_32x32x16_bf16(b1,qr[d0],p1,0,0,0);}}
}
typedef __attribute__((address_space(3))) const char* lds_cptr;
typedef short v4i16_t __attribute__((ext_vector_type(4)));
__device__ __forceinline__ void kload8(bf16x8*kf,lds_cptr kp){
  kf[0]=*(const __attribute__((address_space(3))) bf16x8*)(kp);      kf[1]=*(const __attribute__((address_space(3))) bf16x8*)(kp+512);
  kf[2]=*(const __attribute__((address_space(3))) bf16x8*)(kp+2048); kf[3]=*(const __attribute__((address_space(3))) bf16x8*)(kp+2560);
  kf[4]=*(const __attribute__((address_space(3))) bf16x8*)(kp+4096); kf[5]=*(const __attribute__((address_space(3))) bf16x8*)(kp+4608);
  kf[6]=*(const __attribute__((address_space(3))) bf16x8*)(kp+6144); kf[7]=*(const __attribute__((address_space(3))) bf16x8*)(kp+6656);
}
__device__ __forceinline__ void kload2(bf16x8*kf,lds_cptr kp,int j){ kf[2*j]=*(const __attribute__((address_space(3))) bf16x8*)(kp+j*2048); kf[2*j+1]=*(const __attribute__((address_space(3))) bf16x8*)(kp+j*2048+512); }
__device__ __forceinline__ s16x4 vtr(lds_cptr p){ return __builtin_bit_cast(s16x4,__builtin_amdgcn_ds_read_tr16_b64_v4i16((__attribute__((address_space(3))) v4i16_t*)p)); }
__device__ __forceinline__ float rowmax(const f32x16&p0,const f32x16&p1){
  float a=max3f(p0[0],p0[1],p1[0]),b=max3f(p0[2],p0[3],p1[1]);a=max3f(a,p1[2],p1[3]);
  #pragma unroll
  for(int r=4;r<16;r+=4){a=max3f(a,p0[r],p0[r+1]);b=max3f(b,p0[r+2],p0[r+3]);a=max3f(a,p1[r],p1[r+1]);b=max3f(b,p1[r+2],p1[r+3]);}
  const float m=max2f(a,b);
  auto rr=__builtin_amdgcn_permlane32_swap(__float_as_uint(m),__float_as_uint(m),false,false);
  return max2f(__uint_as_float(rr[0]),__uint_as_float(rr[1]));
}
__device__ __forceinline__ void pv(f32x16*o,int vb,bf16x8 pa0,bf16x8 pa1,bf16x8 pa2,bf16x8 pa3){
  #pragma unroll
  for(int d0=0;d0<2;++d0){s16x4 lo[4],hi[4];
    #pragma unroll
    for(int ks=0;ks<4;++ks){
      asm volatile("ds_read_b64_tr_b16 %0,%1 offset:%c2":"=&v"(lo[ks]):"v"(vb),"i"(d0*4096+ks*1024):"memory");
      asm volatile("ds_read_b64_tr_b16 %0,%1 offset:%c2":"=&v"(hi[ks]):"v"(vb),"i"(d0*4096+ks*1024+512):"memory");}
    asm volatile("s_waitcnt lgkmcnt(0)":::"memory");SBAR();
    #define PK(k) (bf16x8){lo[k][0],lo[k][1],lo[k][2],lo[k][3],hi[k][0],hi[k][1],hi[k][2],hi[k][3]}
    o[d0]=__builtin_amdgcn_mfma_f32_32x32x16_bf16(pa0,PK(0),o[d0],0,0,0);
    o[d0]=__builtin_amdgcn_mfma_f32_32x32x16_bf16(pa1,PK(1),o[d0],0,0,0);
    o[d0]=__builtin_amdgcn_mfma_f32_32x32x16_bf16(pa2,PK(2),o[d0],0,0,0);
    o[d0]=__builtin_amdgcn_mfma_f32_32x32x16_bf16(pa3,PK(3),o[d0],0,0,0);
    #undef PK
  }
}

#ifndef ATTN_STORE16
#define ATTN_STORE16(p,v) (*(u32x4*)(p)=(v))
#endif
template<int THRL> __device__ __forceinline__ void attn_unit(int b,int qkcol,int vcol,int qb,const bf16*Q,const bf16*__restrict__ K,const bf16*__restrict__ V,bf16*O,char*shm){
  int tid_o=threadIdx.x; asm volatile("":"+v"(tid_o)); const int tid=tid_o,lane=tid&63,r32=lane&31,hi=lane>>5; const int wid=__builtin_amdgcn_readfirstlane(tid>>6);
  const long rowbase=(long)b*SEQ; const int q0=qb*QB;
  const bf16*Qw=Q+(rowbase+q0+wid*QBLK)*DM+qkcol;
  const bf16*Kh=K+rowbase*DM+qkcol,*Vh=V+rowbase*DM+vcol;
  const unsigned lds0=(unsigned)(uintptr_t)shm;
  float*wsf=(float*)(shm+LDS_WS)+wid*64;
  const bf16*ksrc=Kh+(long)lane*DM+wid*8;
  const bf16*vsrc=Vh+(long)(16*(wid&3)+(lane>>2))*DM+(wid>>2)*32+(lane&3)*8;
  const unsigned kdst=lds0+LDS_K+wid*1024, vdst=lds0+LDS_V+wid*1024;
  #define DMA_K(t,slot) glds16(ksrc+(long)(t)*KVBLK*DM,(unsigned)__builtin_amdgcn_readfirstlane(kdst+(slot)))
  #define DMA_V(t,slot) glds16(vsrc+(long)(t)*KVBLK*DM,(unsigned)__builtin_amdgcn_readfirstlane(vdst+(slot)))
  const int vb0=(int)(lds0+LDS_V)+((lane>>4)&1)*32+(lane&3)*8+(4*hi+((lane&15)>>2))*64;
  const char*Kbase=shm+LDS_K; bf16x8 kf[8];
  const lds_cptr shm3=(lds_cptr)shm; const lds_cptr kp0=shm3+LDS_K+hi*1024+r32*16; const lds_cptr vp0=shm3+LDS_V+((lane>>4)&1)*32+(lane&3)*8+(4*hi+((lane&15)>>2))*64;
  const int NT=(q0+QB)/KVBLK;
  DMA_K(0,0);DMA_V(0,0);DMA_K(1,SLOTB);
  bf16x8 qr[4];
  #pragma unroll
  for(int d0=0;d0<4;++d0)qr[d0]=*reinterpret_cast<const bf16x8*>(&Qw[(long)r32*DM+d0*16+hi*8]);
  float mhat=0.f,l_reg=0.f;f32x16 o[2];o[0]=f32x16{};o[1]=f32x16{};f32x16 negm=f32x16{};asm volatile("":"+v"(negm));
  const int qrel=wid*QBLK+r32;
  #define CMASK(P0,P1,t) do{int jb_=(t)-(NT-4); if(jb_>=0)cmask(P0,P1,jb_,qrel,hi);}while(0)
  bool resc=false;
  #define START(P0,P1) do{ const float rm=rowmax(P0,P1); resc=false; \
    { const float dl=rm; mhat=fadd_s(mhat,dl); \
      _Pragma("unroll") for(int r=0;r<16;++r){P0[r]=fsub_s(P0[r],dl);P1[r]=fsub_s(P1[r],dl);} \
      _Pragma("unroll") for(int r=0;r<16;++r)negm[r]=-mhat; asm volatile("":"+v"(negm)); } \
    _Pragma("unroll") for(int r=0;r<16;++r)P0[r]=__builtin_amdgcn_exp2f(P0[r]); }while(0)
  #define RESC() do{ if(resc){ asm volatile("s_waitcnt lgkmcnt(0)":::"memory"); \
      _Pragma("unroll") for(int d_=0;d_<2;++d_) _Pragma("unroll") for(int r=0;r<16;++r)o[d_][r]*=wsf[crow(r,hi)]; } }while(0)
  f32x16 pA0,pA1,pB0,pB1;
  int sl_prev=0,sl_cur=0,sl_next=SLOTB;
  #define ROT() do{sl_prev=sl_cur;sl_cur=sl_next;sl_next=(sl_next==(NSLOT-1)*SLOTB)?0:sl_next+SLOTB;}while(0)
  DMA_K(2,2*SLOTB);
  WAIT_BAR(3);
  qkt(pA0,pA1,Kbase,qr,negm,r32,hi);asm volatile("s_nop 15\n\ts_nop 7":"+v"(pA0),"+v"(pA1));CMASK(pA0,pA1,0);
  START(pA0,pA1);
  _Pragma("unroll") for(int r=0;r<16;++r)pA1[r]=__builtin_amdgcn_exp2f(pA1[r]);
  WAIT_BAR(0);
  DMA_K(3,0);DMA_V(1,SLOTB);
  ROT();
  kload8(kf,kp0+sl_cur);
  WAIT_BAR(2);
  s16x4 vlo[8],vhi[8]; u32x4 pw0,pw1,pw2,pw3;
  #define PKW(P,B) cvtpk_s(P[B],P[B+1])
  #define PAF(k) __builtin_bit_cast(bf16x8,pw##k)
  #define VFR(i) (bf16x8){vlo[i][0],vlo[i][1],vlo[i][2],vlo[i][3],vhi[i][0],vhi[i][1],vhi[i][2],vhi[i][3]}
  #define PIN(x) asm volatile("":"+v"(x))
  #define MX3(a,b,c) __builtin_fmaxf(__builtin_fmaxf((a),(b)),(c))
  #define GAPA(MF,A0,A1,A2,A3,W0,W1,PW) do{ MF; sacc+=A0; sacc+=A1; sacc+=A2; sacc+=A3; PIN(sacc); W0; W1; PIN(PW); SBAR(); }while(0)
  #define EX(v) __builtin_amdgcn_exp2f(v)
  #define GAPB(MF,X,B) do{ MF; X[B]=EX(X[B]); X[B+1]=EX(X[B+1]); X[B+2]=EX(X[B+2]); X[B+3]=EX(X[B+3]); PIN(X); SBAR(); }while(0)
  #define VRD(i) do{ vlo[i]=vtr(vp_+(((i)>>2)*4096+((i)&3)*1024)); vhi[i]=vtr(vp_+(((i)>>2)*4096+((i)&3)*1024+512)); }while(0)
  #define KRD(G,j) do{ if(G){ kload2(kf,kp0+sl_next,j); SBAR(); } }while(0)
  #define STEP(C0,C1,P0,P1,t,GK,GV,GL) do{ SBAR(); \
    const lds_cptr vp_=vp0+sl_prev; \
    VRD(0); SBAR(); float sacc=(P0[0]+P0[1]); \
    GAPA(C0=__builtin_amdgcn_mfma_f32_32x32x16_bf16(kf[0],qr[0],negm,0,0,0), P0[2],P0[3],P0[4],P0[5],     pw0[0]=PKW(P0,0), pw0[1]=PKW(P0,2), pw0); \
    VRD(4); SBAR(); GAPA(C1=__builtin_amdgcn_mfma_f32_32x32x16_bf16(kf[1],qr[0],negm,0,0,0), P0[6],P0[7],P0[8],P0[9],     pw0[2]=PKW(P0,4), pw0[3]=PKW(P0,6), pw0); \
    VRD(1); SBAR(); GAPA(C0=__builtin_amdgcn_mfma_f32_32x32x16_bf16(kf[2],qr[1],C0,0,0,0),   P0[10],P0[11],P0[12],P0[13], pw1[0]=PKW(P0,8), pw1[1]=PKW(P0,10), pw1); \
    VRD(5); SBAR(); GAPA(C1=__builtin_amdgcn_mfma_f32_32x32x16_bf16(kf[3],qr[1],C1,0,0,0),   P0[14],P0[15],P1[0],P1[1],   pw1[2]=PKW(P0,12),pw1[3]=PKW(P0,14), pw1); \
    VRD(2); SBAR(); GAPA(C0=__builtin_amdgcn_mfma_f32_32x32x16_bf16(kf[4],qr[2],C0,0,0,0),   P1[2],P1[3],P1[4],P1[5],     pw2[0]=PKW(P1,0), pw2[1]=PKW(P1,2), pw2); \
    VRD(6); SBAR(); GAPA(C1=__builtin_amdgcn_mfma_f32_32x32x16_bf16(kf[5],qr[2],C1,0,0,0),   P1[6],P1[7],P1[8],P1[9],     pw2[2]=PKW(P1,4), pw2[3]=PKW(P1,6), pw2); \
    VRD(3); SBAR(); GAPA(C0=__builtin_amdgcn_mfma_f32_32x32x16_bf16(kf[6],qr[3],C0,0,0,0),   P1[10],P1[11],P1[12],P1[13], pw3[0]=PKW(P1,8), pw3[1]=PKW(P1,10), pw3); \
    VRD(7); SBAR(); GAPA(C1=__builtin_amdgcn_mfma_f32_32x32x16_bf16(kf[7],qr[3],C1,0,0,0),   P1[14],P1[15],0.f,0.f,       pw3[2]=PKW(P1,12),pw3[3]=PKW(P1,14), pw3); \
    l_reg+=sacc; \
    if(GK){DMA_K((t)+3,sl_cur);} if(GV){DMA_V((t)+1,sl_next);} \
    CMASK(C0,C1,t); \
    { float a=MX3(C0[0],C0[1],C1[0]),b=MX3(C0[2],C0[3],C1[1]); a=MX3(a,C1[2],C1[3]); \
      _Pragma("unroll") for(int r=4;r<16;r+=4){a=MX3(a,C0[r],C0[r+1]);b=MX3(b,C0[r+2],C0[r+3]);a=MX3(a,C1[r],C1[r+1]);b=MX3(b,C1[r+2],C1[r+3]);} \
      float rm=__builtin_fmaxf(a,b); { auto rr=__builtin_amdgcn_permlane32_swap(__float_as_uint(rm),__float_as_uint(rm),false,false); rm=__builtin_fmaxf(__uint_as_float(rr[0]),__uint_as_float(rr[1])); } \
      resc=false; \
      if(__builtin_expect(__any(rm>(float)THRL),0)){ const float dl=__builtin_fmaxf(rm,0.f); mhat+=dl; \
        _Pragma("unroll") for(int r=0;r<16;++r){C0[r]-=dl;C1[r]-=dl;} \
        _Pragma("unroll") for(int r=0;r<16;++r)negm[r]=-mhat; asm volatile("":"+v"(negm)); \
        const float f=__builtin_amdgcn_exp2f(-dl); l_reg*=f; if(hi==0)wsf[r32]=f; resc=true; } } \
    SBAR(); \
    GAPB(o[0]=__builtin_amdgcn_mfma_f32_32x32x16_bf16(PAF(0),VFR(0),o[0],0,0,0), C0,0); \
    GAPB(o[1]=__builtin_amdgcn_mfma_f32_32x32x16_bf16(PAF(0),VFR(4),o[1],0,0,0), C0,4); \
    KRD(GL,0); GAPB(o[0]=__builtin_amdgcn_mfma_f32_32x32x16_bf16(PAF(1),VFR(1),o[0],0,0,0), C0,8); \
    KRD(GL,1); GAPB(o[1]=__builtin_amdgcn_mfma_f32_32x32x16_bf16(PAF(1),VFR(5),o[1],0,0,0), C0,12); \
    KRD(GL,2); GAPB(o[0]=__builtin_amdgcn_mfma_f32_32x32x16_bf16(PAF(2),VFR(2),o[0],0,0,0), C1,0); \
    KRD(GL,3); GAPB(o[1]=__builtin_amdgcn_mfma_f32_32x32x16_bf16(PAF(2),VFR(6),o[1],0,0,0), C1,4); \
    GAPB(o[0]=__builtin_amdgcn_mfma_f32_32x32x16_bf16(PAF(3),VFR(3),o[0],0,0,0), C1,8); \
    GAPB(o[1]=__builtin_amdgcn_mfma_f32_32x32x16_bf16(PAF(3),VFR(7),o[1],0,0,0), C1,12); \
    }while(0)
  int t=1;
  #undef CMASK
  #define CMASK(P0,P1,t) do{}while(0)
  for(;t+5<NT;t+=2){
    STEP(pB0,pB1,pA0,pA1,t,true,true,true);     WAIT_BAR(2); RESC(); ROT();
    STEP(pA0,pA1,pB0,pB1,t+1,true,true,true);   WAIT_BAR(2); RESC(); ROT();
  }
  #undef CMASK
  #define CMASK(P0,P1,t) do{int jb_=(t)-(NT-4); if(jb_>=0)cmask(P0,P1,jb_,qrel,hi);}while(0)
  #define ENDW(tt) do{ if((tt)+3<NT){WAIT_BAR(2);} else if((tt)+2<NT){WAIT_BAR(1);} else {WAIT_BAR(0);} }while(0)
  for(;t+1<NT;t+=2){
    STEP(pB0,pB1,pA0,pA1,t,(t+3<NT),(t+1<NT),(t+1<NT));       ENDW(t);   RESC(); ROT();
    STEP(pA0,pA1,pB0,pB1,t+1,(t+4<NT),(t+2<NT),(t+2<NT));     ENDW(t+1); RESC(); ROT();
  }
  STEP(pB0,pB1,pA0,pA1,NT-1,false,false,false); RESC();
  { float sacc=pB0[0]+pB0[1]; _Pragma("unroll") for(int r=2;r<16;++r)sacc+=pB0[r]; _Pragma("unroll") for(int r=0;r<16;++r)sacc+=pB1[r]; l_reg+=sacc;
    pw0=(u32x4){PKW(pB0,0),PKW(pB0,2),PKW(pB0,4),PKW(pB0,6)};pw1=(u32x4){PKW(pB0,8),PKW(pB0,10),PKW(pB0,12),PKW(pB0,14)};pw2=(u32x4){PKW(pB1,0),PKW(pB1,2),PKW(pB1,4),PKW(pB1,6)};pw3=(u32x4){PKW(pB1,8),PKW(pB1,10),PKW(pB1,12),PKW(pB1,14)};
    SBAR(); pv(o,vb0+sl_cur,PAF(0),PAF(1),PAF(2),PAF(3)); }
  #undef PKW
  #undef PAF
  #undef VFR
  #undef PIN
  #undef MX3
  #undef GAPA
  #undef GAPB
  #undef EX
  #undef VRD
  #undef KRD
  #undef STEP
  #undef ENDW
  {auto rr=__builtin_amdgcn_permlane32_swap(__float_as_uint(l_reg),__float_as_uint(l_reg),false,false);l_reg=__uint_as_float(rr[0])+__uint_as_float(rr[1]);}
  if(hi==0)wsf[32+r32]=l_reg;asm volatile("s_waitcnt lgkmcnt(0)":::"memory");
  float rli[16];
  #pragma unroll
  for(int r=0;r<16;++r)rli[r]=__builtin_amdgcn_rcpf(wsf[32+crow(r,hi)]);
  bf16*Ow=O+(rowbase+q0+wid*QBLK)*DM+vcol;
  { bf16*stg=(bf16*)(shm+LDS_OST)+wid*2048;
    #pragma unroll
    for(int r=0;r<16;++r){const int orow=crow(r,hi);
      #pragma unroll
      for(int d0=0;d0<2;++d0)stg[orow*64+d0*32+r32]=__float2bfloat16(o[d0][r]*rli[r]);}
    asm volatile("s_waitcnt lgkmcnt(0)":::"memory");
    #pragma unroll
    for(int i=0;i<4;++i){const int row=i*8+(lane>>3),ch=lane&7; const u32x4 v=*(const u32x4*)(stg+row*64+ch*8); ATTN_STORE16(Ow+(long)row*DM+ch*8,v);} }
  asm volatile("s_waitcnt lgkmcnt(0)\n\ts_barrier":::"memory");
  #undef DMA_K
  #undef DMA_V
  #undef CMASK
  #undef START
  #undef RESC
  #undef ROT
}
constexpr int ATTN_LDS_BYTES=LDS_BYTES;
struct AttnTensors { const bf16* Q; const bf16* K; const bf16* V; bf16* O0; bf16* O1; };
struct AttnUnit { int bh; int vh; int qb; };
struct StaticOrder {
  int vcu;
  __device__ __forceinline__ explicit StaticOrder(int grid,int block):vcu((block%8)*(grid/8)+block/8){}
  __device__ __forceinline__ bool next(int i,AttnUnit&u)const{ if(i>=8)return false; const int s=vcu&7,k=i&3; u.bh=vcu>>3; u.vh=i>>2; u.qb=(k==0)?s:(k==1)?15-s:(k==2)?16+s:31-s; return true; }
};
template<class Sched,int THRL=8> __device__ __forceinline__ void attn_phase(char*lds,const AttnTensors&T,const Sched&S){
  AttnUnit u;
  for(int i=0;S.next(i,u);++i){ const int b=u.bh/NHEAD,hh=u.bh%NHEAD; attn_unit<THRL>(b,hh*64,(hh>>1)*128+u.vh*64,u.qb,T.Q,T.K,T.V,(hh&1)?T.O1:T.O0,lds); }
}
#undef SBAR
#undef WAIT_BAR
}
#define GAS __attribute__((address_space(1)))
#define LAS __attribute__((address_space(3)))
typedef unsigned short bf16;
typedef unsigned v4u __attribute__((ext_vector_type(4)));
typedef float f32x4 __attribute__((ext_vector_type(4)));
typedef short bf16x8 __attribute__((ext_vector_type(8)));
typedef GAS unsigned gu32;
typedef GAS unsigned long long gu64;
#define RLX_AGENT __ATOMIC_RELAXED, __HIP_MEMORY_SCOPE_AGENT
#define LDS_WAIT() asm volatile("s_waitcnt lgkmcnt(0)" ::: "memory")
#define VM_WAIT() asm volatile("s_waitcnt vmcnt(0)" ::: "memory")
__device__ __forceinline__ unsigned long long rt() { return __builtin_amdgcn_s_memrealtime(); }
__device__ __forceinline__ unsigned f2bf(float f) { unsigned u = __builtin_bit_cast(unsigned, f); return (u + 0x7fffu + ((u >> 16) & 1u)) >> 16; }
__device__ __forceinline__ unsigned pk2(float lo, float hi) { return f2bf(lo) | (f2bf(hi) << 16); }

#define XB_TMO      128
#define XB_XCNT(j)  (256  + 64 * (j))
#define XB_XSUB(j)  (1280 + 64 * (j))
#define XB_XGEN(j)  (2304 + 64 * (j))
#define XB_TOP      3328
#define XB_TOPGEN   3392
#define XCD_BAR_WORDS 3456
#define XB_SPIN_CAP (1u << 18)

__device__ __forceinline__ unsigned xb_ld(unsigned* p)              { return __hip_atomic_load(p, __ATOMIC_RELAXED, __HIP_MEMORY_SCOPE_AGENT); }
__device__ __forceinline__ unsigned xb_add(unsigned* p, unsigned v) { return __hip_atomic_fetch_add(p, v, __ATOMIC_RELAXED, __HIP_MEMORY_SCOPE_AGENT); }
__device__ __forceinline__ unsigned xb_xcc_id() { return (unsigned)__builtin_amdgcn_s_getreg((3 << 11) | 20) & 0xFu; }
#define XB_SPIN(cond, bar) do { unsigned _sp = 0; while (cond) { __builtin_amdgcn_s_sleep(1); \
    if ((++_sp & 255u) == 0u) { if (xb_ld(&(bar)[XB_TMO])) break; if (_sp > XB_SPIN_CAP) { atomicAdd(&(bar)[XB_TMO], 1u); break; } } } } while (0)

struct XcdBarrier {
    unsigned* bar; unsigned x;
    volatile LAS unsigned* st;
};

__device__ __forceinline__ XcdBarrier xcd_barrier_post(unsigned* bar, volatile LAS unsigned* st) {
    XcdBarrier b; b.bar = bar; b.x = xb_xcc_id(); b.st = st;
    if (threadIdx.x == 0) (void)xb_add(&bar[XB_XCNT(b.x)], 1u);
    return b;
}
__device__ __forceinline__ void xcd_barrier_complete(unsigned* bar, unsigned x, unsigned& nloc, unsigned& nx) {
    const unsigned G = gridDim.x * gridDim.y * gridDim.z;
    unsigned sum, cnt, mine, sp = 0u;
    for (;;) {
        sum = 0u; cnt = 0u; mine = 0u;
#pragma unroll
        for (unsigned j = 0; j < 16; ++j) { const unsigned c = xb_ld(&bar[XB_XCNT(j)]); sum += c; cnt += (c > 0u) ? 1u : 0u; mine = (j == x) ? c : mine; }
        if (sum == G) break;
        __builtin_amdgcn_s_sleep(1);
        if ((++sp & 255u) == 0u) { if (xb_ld(&bar[XB_TMO])) break; if (sp > XB_SPIN_CAP) { atomicAdd(&bar[XB_TMO], 1u); break; } }
    }
    nloc = mine > 0u ? mine : 1u; nx = cnt > 0u ? cnt : 1u;
}

__device__ __forceinline__ void xcd_barrier(const XcdBarrier& b) {
    asm volatile("s_waitcnt vmcnt(0)" ::: "memory");
    __syncthreads();
    if (threadIdx.x == 0) {
        unsigned* bar = b.bar;
        __builtin_amdgcn_s_waitcnt(0);
        unsigned nloc = b.st[0], nx = b.st[1];
        if (nloc == 0u) { xcd_barrier_complete(bar, b.x, nloc, nx); b.st[0] = nloc; b.st[1] = nx; }
        const unsigned old = xb_add(&bar[XB_XSUB(b.x)], 1u);
        const unsigned gen = old / nloc;
        if (old + 1u == (gen + 1u) * nloc) {
            __builtin_amdgcn_fence(__ATOMIC_RELEASE, "agent");
            asm volatile("s_waitcnt vmcnt(0)" ::: "memory");
            const unsigned og = xb_add(&bar[XB_TOP], 1u);
            const unsigned tg = og / nx;
            if (og + 1u == (tg + 1u) * nx) xb_add(&bar[XB_TOPGEN], 1u);
            else XB_SPIN(xb_ld(&bar[XB_TOPGEN]) == tg, bar);
            __builtin_amdgcn_fence(__ATOMIC_ACQUIRE, "agent");
            xb_add(&bar[XB_XGEN(b.x)], 1u);
            asm volatile("s_waitcnt vmcnt(0)" ::: "memory");
        } else {
            XB_SPIN(xb_ld(&bar[XB_XGEN(b.x)]) == gen, bar);
            __builtin_amdgcn_fence(__ATOMIC_ACQUIRE, "agent");
            asm volatile("s_waitcnt vmcnt(0)" ::: "memory");
        }
    }
    __syncthreads();
}
namespace ret {
#define RLAS __attribute__((address_space(3)))
typedef unsigned short bf16_t;
typedef float f32x16 __attribute__((ext_vector_type(16)));
typedef float f32x4 __attribute__((ext_vector_type(4)));
typedef float f32x2 __attribute__((ext_vector_type(2)));
typedef short bf16x8 __attribute__((ext_vector_type(8)));
typedef short s16x4 __attribute__((ext_vector_type(4)));
typedef unsigned u32x4 __attribute__((ext_vector_type(4)));
typedef unsigned u32x2 __attribute__((ext_vector_type(2)));
typedef __bf16 bf16x2_t __attribute__((ext_vector_type(2)));
constexpr int QS = 272, KRS = 272, KTS = 320, VTS = 576;
constexpr int L_Q = 0, L_KR = 64 * QS, L_KT = L_KR + 64 * KRS, L_V = L_KT + 64 * KTS, L_ST = L_V + 64 * VTS, L_END = L_ST + 8 * 64 * 8;
constexpr float GN_EPS = 1e-6f;
__device__ __forceinline__ unsigned pkbf(float lo, float hi) { f32x2 v = {lo, hi}; bf16x2_t b = __builtin_convertvector(v, bf16x2_t); return __builtin_bit_cast(unsigned, b); }
template <int S> __device__ __forceinline__ bf16x8 cvt8(const f32x16& x) {
    u32x4 w; w.x = pkbf(x[8 * S + 0], x[8 * S + 1]); w.y = pkbf(x[8 * S + 2], x[8 * S + 3]); w.z = pkbf(x[8 * S + 4], x[8 * S + 5]); w.w = pkbf(x[8 * S + 6], x[8 * S + 7]);
    return __builtin_bit_cast(bf16x8, w);
}
__device__ __forceinline__ bf16x8 trfrag(RLAS const unsigned char* p, int step8) {
    typedef short v4i16_t __attribute__((ext_vector_type(4)));
    const s16x4 lo = __builtin_bit_cast(s16x4, __builtin_amdgcn_ds_read_tr16_b64_v4i16((RLAS v4i16_t*)p));
    const s16x4 hi = __builtin_bit_cast(s16x4, __builtin_amdgcn_ds_read_tr16_b64_v4i16((RLAS v4i16_t*)(p + step8)));
    return (bf16x8){lo[0], lo[1], lo[2], lo[3], hi[0], hi[1], hi[2], hi[3]};
}
#define RMFMA(a, b, c) __builtin_amdgcn_mfma_f32_32x32x16_bf16(a, b, c, 0, 0, 0)

struct Bufs { const bf16_t* Q; const bf16_t* KD; bf16_t* V; float* L; const float* lgtab; };

template <bool FULL> __device__ __forceinline__ void stage(RLAS unsigned char* lds, const Bufs& B, size_t row0, int h, int tid) {
    u32x4 kq[2], kk[2], vv[4];
#pragma unroll
    for (int i = 0; i < 2; ++i) { const int piece = tid + 512 * i, row = piece >> 4, ch = piece & 15; const size_t off = (row0 + row) * 1024 + h * 128 + ch * 8;
        kk[i] = *(const u32x4*)(B.KD + off); if (FULL) kq[i] = *(const u32x4*)(B.Q + off); }
#pragma unroll
    for (int i = 0; i < 4; ++i) { const int piece = tid + 512 * i, row = piece >> 5, ch = piece & 31; vv[i] = *(const u32x4*)(B.V + (row0 + row) * 2048 + h * 256 + ch * 8); }
#pragma unroll
    for (int i = 0; i < 2; ++i) { const int piece = tid + 512 * i, row = piece >> 4, ch = piece & 15;
        *(RLAS u32x4*)(lds + L_KT + row * KTS + ch * 16) = kk[i];
        if (FULL) { *(RLAS u32x4*)(lds + L_KR + row * KRS + ch * 16) = kk[i]; *(RLAS u32x4*)(lds + L_Q + row * QS + ch * 16) = kq[i]; } }
#pragma unroll
    for (int i = 0; i < 4; ++i) { const int piece = tid + 512 * i, row = piece >> 5, ch = piece & 31; *(RLAS u32x4*)(lds + L_V + row * VTS + ch * 16) = vv[i]; }
}

__device__ __forceinline__ void state_update(f32x16 (&st)[4], const bf16x8 (&vf)[4], RLAS const unsigned char* kbase, float cd) {
#pragma unroll
    for (int dt = 0; dt < 4; ++dt) st[dt] = st[dt] * cd;
#pragma unroll
    for (int ks = 0; ks < 4; ++ks)
#pragma unroll
        for (int dt = 0; dt < 4; ++dt) { const bf16x8 a = trfrag(kbase + ks * 16 * KTS + dt * 64, 8 * KTS); st[dt] = RMFMA(a, vf[ks], st[dt]); }
    __builtin_amdgcn_sched_barrier(0);
}

__device__ __forceinline__ void r1_unit(RLAS unsigned char* lds, const Bufs& B, int unit) {
    int tid_o = threadIdx.x; asm volatile("" : "+v"(tid_o));
    const int tid = tid_o, lane = tid & 63, w = __builtin_amdgcn_readfirstlane(tid >> 6), hh = lane >> 5, g1 = (lane >> 4) & 1, q = (lane & 15) >> 2, p = lane & 3;
    const int g = unit & 15, h = (unit >> 4) & 7, b = unit >> 7;
    const float lg = B.lgtab[h], cd = __builtin_amdgcn_exp2f(64.f * lg);
    RLAS const unsigned char* vbase = lds + L_V + (4 * hh + q) * VTS + (32 * w + 16 * g1 + 4 * p) * 2;
    RLAS const unsigned char* kbase = lds + L_KT + (4 * hh + q) * KTS + (16 * g1 + 4 * p) * 2;
    f32x16 st[4];
#pragma unroll
    for (int dt = 0; dt < 4; ++dt)
#pragma unroll
        for (int e = 0; e < 16; ++e) st[dt][e] = 0.f;
    const size_t row0 = (size_t)b * 8192 + (size_t)g * 512;
    for (int j = 0; j < 8; ++j) {
        __syncthreads();
        stage<false>(lds, B, row0 + 64 * j, h, tid);
        __syncthreads();
        bf16x8 vf[4];
#pragma unroll
        for (int ks = 0; ks < 4; ++ks) vf[ks] = trfrag(vbase + ks * 16 * VTS, 8 * VTS);
        state_update(st, vf, kbase, cd);
    }
    float* Lp = B.L + ((size_t)unit * 8 + w) * 4096 + lane * 4;
#pragma unroll
    for (int dt = 0; dt < 4; ++dt)
#pragma unroll
        for (int k4 = 0; k4 < 4; ++k4) *(f32x4*)(Lp + (dt * 4 + k4) * 256) = (f32x4){st[dt][4 * k4], st[dt][4 * k4 + 1], st[dt][4 * k4 + 2], st[dt][4 * k4 + 3]};
}

__device__ __forceinline__ void r3_unit(RLAS unsigned char* lds, const Bufs& B, int unit) {
    int tid_o = threadIdx.x; asm volatile("" : "+v"(tid_o));
    const int tid = tid_o, lane = tid & 63, w = __builtin_amdgcn_readfirstlane(tid >> 6), r = lane & 31, hh = lane >> 5, g1 = (lane >> 4) & 1, q = (lane & 15) >> 2, p = lane & 3;
    const int g = unit & 15, h = (unit >> 4) & 7, b = unit >> 7;
    const float lg = B.lgtab[h], cd = __builtin_amdgcn_exp2f(64.f * lg), cd8 = __builtin_amdgcn_exp2f(512.f * lg);
    float qdec[2], smask[2];
#pragma unroll
    for (int ct = 0; ct < 2; ++ct) { const float c = (float)(32 * ct + r); qdec[ct] = __builtin_amdgcn_exp2f((c + 1.f) * lg); smask[ct] = __builtin_amdgcn_exp2f((c - 63.f) * lg); }
    RLAS const unsigned char* vbase = lds + L_V + (4 * hh + q) * VTS + (32 * w + 16 * g1 + 4 * p) * 2;
    RLAS const unsigned char* kbase = lds + L_KT + (4 * hh + q) * KTS + (16 * g1 + 4 * p) * 2;
    RLAS const unsigned char* qrow = lds + L_Q + r * QS + hh * 16;
    RLAS const unsigned char* krow = lds + L_KR + r * KRS + hh * 16;
    RLAS const unsigned char* qprm = lds + L_Q + r * QS + hh * 8;
    RLAS f32x2* ST = (RLAS f32x2*)(lds + L_ST);
    f32x16 st[4];
#pragma unroll
    for (int dt = 0; dt < 4; ++dt)
#pragma unroll
        for (int e = 0; e < 16; ++e) st[dt][e] = 0.f;
    for (int gp = 0; gp < g; ++gp) {
        const float* Lp = B.L + ((size_t)(unit - g + gp) * 8 + w) * 4096 + lane * 4;
#pragma unroll
        for (int dt = 0; dt < 4; ++dt)
#pragma unroll
            for (int k4 = 0; k4 < 4; ++k4) { const f32x4 v = *(const f32x4*)(Lp + (dt * 4 + k4) * 256);
#pragma unroll
                for (int e = 0; e < 4; ++e) st[dt][4 * k4 + e] = st[dt][4 * k4 + e] * cd8 + v[e]; }
    }
    const size_t row0 = (size_t)b * 8192 + (size_t)g * 512;
    for (int j = 0; j < 8; ++j) {
        __syncthreads();
        stage<true>(lds, B, row0 + 64 * j, h, tid);
        __syncthreads();
        bf16x8 vf[4];
#pragma unroll
        for (int ks = 0; ks < 4; ++ks) vf[ks] = trfrag(vbase + ks * 16 * VTS, 8 * VTS);
        f32x16 oT[2];
#pragma unroll
        for (int ct = 0; ct < 2; ++ct)
#pragma unroll
            for (int e = 0; e < 16; ++e) oT[ct][e] = 0.f;
#pragma unroll
        for (int dt = 0; dt < 4; ++dt) {
            const bf16x8 a0 = cvt8<0>(st[dt]), a1 = cvt8<1>(st[dt]);
#pragma unroll
            for (int ct = 0; ct < 2; ++ct) {
                RLAS const unsigned char* qp = qprm + ct * 32 * QS + dt * 64;
                const u32x2 l0 = *(RLAS const u32x2*)(qp), h0 = *(RLAS const u32x2*)(qp + 16), l1 = *(RLAS const u32x2*)(qp + 32), h1 = *(RLAS const u32x2*)(qp + 48);
                const bf16x8 b0 = __builtin_bit_cast(bf16x8, (u32x4){l0.x, l0.y, h0.x, h0.y}), b1 = __builtin_bit_cast(bf16x8, (u32x4){l1.x, l1.y, h1.x, h1.y});
                oT[ct] = RMFMA(a0, b0, oT[ct]); oT[ct] = RMFMA(a1, b1, oT[ct]);
            }
            __builtin_amdgcn_sched_barrier(0);
        }
#pragma unroll
        for (int ct = 0; ct < 2; ++ct) oT[ct] = oT[ct] * qdec[ct];
#pragma unroll
        for (int ct = 0; ct < 2; ++ct)
#pragma unroll
            for (int ctp = 0; ctp <= ct; ++ctp) {
                f32x16 sT;
#pragma unroll
                for (int e = 0; e < 16; ++e) sT[e] = 0.f;
#pragma unroll
                for (int ks = 0; ks < 8; ++ks) { const bf16x8 a = *(RLAS const bf16x8*)(krow + ctp * 32 * KRS + ks * 32), bq = *(RLAS const bf16x8*)(qrow + ct * 32 * QS + ks * 32); sT = RMFMA(a, bq, sT); }
#pragma unroll
                for (int e = 0; e < 16; ++e) { const int cp = (e & 3) + 8 * (e >> 2) + 4 * hh; const bool keep = (ctp < ct) || (cp <= r); sT[e] = keep ? sT[e] * smask[ct] : 0.f; }
                oT[ct] = RMFMA(vf[2 * ctp], cvt8<0>(sT), oT[ct]); oT[ct] = RMFMA(vf[2 * ctp + 1], cvt8<1>(sT), oT[ct]);
                __builtin_amdgcn_sched_barrier(0);
            }
#pragma unroll
        for (int ct = 0; ct < 2; ++ct) { float s1 = 0.f, s2 = 0.f;
#pragma unroll
            for (int e = 0; e < 16; ++e) { s1 += oT[ct][e]; s2 += oT[ct][e] * oT[ct][e]; }
            s1 += __shfl_xor(s1, 32); s2 += __shfl_xor(s2, 32);
            if (hh == 0) ST[w * 64 + 32 * ct + r] = (f32x2){s1, s2}; }
        __syncthreads();
#pragma unroll
        for (int ct = 0; ct < 2; ++ct) { float s1 = 0.f, s2 = 0.f;
#pragma unroll
            for (int ww = 0; ww < 8; ++ww) { const f32x2 t = ST[ww * 64 + 32 * ct + r]; s1 += t.x; s2 += t.y; }
            const float mean = s1 * (1.f / 256.f), var = fmaxf(s2 * (1.f / 256.f) - mean * mean, 0.f), rstd = 1.0f / sqrtf(var + GN_EPS);
            bf16_t* op = B.V + (row0 + 64 * j + 32 * ct + r) * 2048 + h * 256 + 32 * w + 4 * hh;
#pragma unroll
            for (int k4 = 0; k4 < 4; ++k4) { u32x2 o; o.x = pkbf((oT[ct][4 * k4] - mean) * rstd, (oT[ct][4 * k4 + 1] - mean) * rstd); o.y = pkbf((oT[ct][4 * k4 + 2] - mean) * rstd, (oT[ct][4 * k4 + 3] - mean) * rstd);
                *(u32x2*)(op + 8 * k4) = o; } }
        state_update(st, vf, kbase, cd);
    }
}
#undef RMFMA
#undef RLAS
}
constexpr int NWAVES = 8;
constexpr int BATCH = 2, SEQ = 8192, DM = 1024, M = BATCH * SEQ;
constexpr float EPS = 1e-6f;
constexpr float C2 = 0.125f * 1.4426950408889634f;
constexpr float LAMBDA_INIT2 = 0.4707130183384360f;
constexpr float LAMBDA_INIT3 = 0.5560582041564060f;

constexpr size_t MiB = 1u << 20;
constexpr size_t WS_CTL = 0, CTL_ZERO_BYTES = 64 * 1024;
constexpr size_t WS_MISC = 512 * 1024;
constexpr size_t WS_CS128 = 1 * MiB;
constexpr size_t WS_CS64 = 5 * MiB;
constexpr size_t WS_WINA = 8 * MiB;
constexpr size_t WS_WOUTA = 32 * MiB;
constexpr size_t WS_WKVQ = 40 * MiB;
constexpr size_t WS_W3 = 48 * MiB;
constexpr size_t WS_WOUTB = 52 * MiB;
constexpr size_t WS_XN = 56 * MiB;
constexpr size_t WS_R = 88 * MiB;
constexpr size_t WS_L = 216 * MiB;
constexpr size_t WS_END = 248 * MiB;
constexpr int CW_BAR = 1024;

constexpr int RING_OFF = 0, RING_BYTES = 131072;
constexpr int LDSCTL_OFF = RING_BYTES, MISC_OFF = LDSCTL_OFF + 320;
constexpr int LDS_BYTES = 147456;

struct Args {
    const float* x; const float* pre_norm; const float* post_norm; const float* w_in_a; const float* w_out_a; const float* kv_norm; const float* w_kv; const float* w_in_b;
    const float* lam_q1; const float* lam_k1; const float* lam_q2; const float* lam_k2; const float* sub_norm_b; const float* w_out_b;
    float* out; unsigned char* ws; int ph_lo, ph_hi, use_bar, pad;
};

__device__ __forceinline__ float wave_sum(float v) {
#pragma unroll
    for (int o = 1; o < 64; o <<= 1) v += __shfl_xor(v, o);
    return v;
}
__device__ __forceinline__ unsigned pkbf(float lo, float hi) { return pg8::pkbf(lo, hi); }

template <int PERM> __device__ __forceinline__ void transpose_item(const float* W, int ldw, int c0, int ncols, int K, const float* gain, bf16* WT, int row_off, int plim, LAS float* scr, int item, int lane) {
    const int nblk = ncols / 32, kb = item / nblk, nb = item % nblk, k0 = 64 * kb, n0 = 32 * nb;
#pragma unroll 8
    for (int i = 0; i < 32; ++i) { const int kk = 2 * i + (lane >> 5); float v = W[(size_t)(k0 + kk) * ldw + c0 + n0 + (lane & 31)]; if (gain) v *= gain[k0 + kk]; scr[kk * 33 + (lane & 31)] = v; }
    LDS_WAIT(); asm volatile("" ::: "memory");
    const int c = lane & 7;
#pragma unroll
    for (int j = 0; j < 4; ++j) { const int n = (lane >> 3) + 8 * j, nn = n0 + n; const LAS float* s = scr + (8 * c) * 33 + n;
        int dr = nn;
        if (PERM == 1 && nn < plim) dr = (nn & ~127) | (2 * (nn & 63) + ((nn >> 6) & 1));
        if (PERM == 2 && nn < plim) dr = (nn & ~63) | (2 * (nn & 31) + ((nn >> 5) & 1));
        v4u o; o.x = pkbf(s[0 * 33], s[1 * 33]); o.y = pkbf(s[2 * 33], s[3 * 33]); o.z = pkbf(s[4 * 33], s[5 * 33]); o.w = pkbf(s[6 * 33], s[7 * 33]);
        *(GAS v4u*)(WT + (size_t)(row_off + dr) * K + k0 + 8 * c) = o; }
    LDS_WAIT(); asm volatile("" ::: "memory");
}
__device__ __forceinline__ void row_to_xn(const float* xrow, bf16* orow, int lane) {
    const GAS f32x4* xr = (const GAS f32x4*)xrow + lane;
    f32x4 v[4]; float s = 0.f;
#pragma unroll
    for (int j = 0; j < 4; ++j) { v[j] = xr[64 * j]; s += (v[j].x * v[j].x + v[j].y * v[j].y) + (v[j].z * v[j].z + v[j].w * v[j].w); }
    const float rstd = 1.f / sqrtf(wave_sum(s) * (1.f / DM) + EPS);
    GAS unsigned long long* o8 = (GAS unsigned long long*)orow + lane;
#pragma unroll
    for (int j = 0; j < 4; ++j) o8[64 * j] = (unsigned long long)pkbf(v[j].x * rstd, v[j].y * rstd) | ((unsigned long long)pkbf(v[j].z * rstd, v[j].w * rstd) << 32);
}
__device__ __forceinline__ void sincos_rev(float ang, float& c, float& s) {
    const double t = (double)ang * 0.15915494309189535; const float f = (float)(t - __builtin_rint(t));
    s = __builtin_amdgcn_sinf(f); c = __builtin_amdgcn_cosf(f);
}

__device__ __forceinline__ void p0_prologue(const Args& A, LAS unsigned char* lds, int vcu, int G, int wave, int lane, int tid) {
    unsigned char* ws = A.ws;
    LAS float* scr = (LAS float*)(lds + RING_OFF + wave * 16384);
    const int gw = vcu * NWAVES + wave, NGW = G * NWAVES;
    bf16* WinA = (bf16*)(ws + WS_WINA); bf16* WoutA = (bf16*)(ws + WS_WOUTA); bf16* Wkvq = (bf16*)(ws + WS_WKVQ); bf16* W3 = (bf16*)(ws + WS_W3); bf16* WoutB = (bf16*)(ws + WS_WOUTB);
    constexpr int I_INA = 16 * 192, I_OUTA = 32 * 32, I_KV = 16 * 64, I_INB = 16 * 64, I_OUTB = 16 * 32;
    constexpr int NITEMS = 2 * I_INA + 2 * I_OUTA + I_KV + 2 * I_INB + 2 * I_OUTB;
    for (int it = gw; it < NITEMS; it += NGW) {
        int r = it;
        if (r < 2 * I_INA) { const int l = r / I_INA; r -= l * I_INA;
            transpose_item<1>(A.w_in_a + (size_t)l * 1024 * 6144, 6144, 0, 6144, 1024, A.pre_norm + l * 1024, WinA + (size_t)l * 6144 * 1024, 0, 2048, scr, r, lane); continue; }
        r -= 2 * I_INA;
        if (r < 2 * I_OUTA) { const int l = r / I_OUTA; r -= l * I_OUTA;
            transpose_item<0>(A.w_out_a + (size_t)l * 2048 * 1024, 1024, 0, 1024, 2048, nullptr, WoutA + (size_t)l * 1024 * 2048, 0, 0, scr, r, lane); continue; }
        r -= 2 * I_OUTA;
        if (r < I_KV) { transpose_item<2>(A.w_kv, 2048, 0, 2048, 1024, A.kv_norm, Wkvq, 0, 1024, scr, r, lane); continue; }
        r -= I_KV;
        if (r < I_INB) { transpose_item<2>(A.w_in_b, 2048, 0, 2048, 1024, A.pre_norm + 2 * 1024, Wkvq, 2048, 1024, scr, r, lane); continue; }
        r -= I_INB;
        if (r < I_INB) { transpose_item<2>(A.w_in_b + (size_t)1024 * 2048, 2048, 0, 2048, 1024, A.pre_norm + 3 * 1024, W3, 0, 1024, scr, r, lane); continue; }
        r -= I_INB;
        { const int l = r / I_OUTB; r -= l * I_OUTB;
          transpose_item<0>(A.w_out_b + (size_t)l * 1024 * 1024, 1024, 0, 1024, 1024, nullptr, WoutB + (size_t)l * 1024 * 1024, 0, 0, scr, r, lane); }
    }
    { float* cs128 = (float*)(ws + WS_CS128); float* cs64 = (float*)(ws + WS_CS64); const int gt = vcu * (NWAVES * 64) + tid, NGT = G * NWAVES * 64;
      for (int e = gt; e < 8192 * 64; e += NGT) { const int pos = e >> 6, i = e & 63; const float inv = powf(10000.0f, -(float)i / 64.0f); float c, s; sincos_rev((float)pos * inv, c, s); *(float2*)(cs128 + 2 * (size_t)e) = make_float2(c, s); }
      for (int e = gt; e < 8192 * 32; e += NGT) { const int pos = e >> 5, i = e & 31; const float inv = powf(10000.0f, -(float)i / 32.0f); float c, s; sincos_rev((float)pos * inv, c, s); *(float2*)(cs64 + 2 * (size_t)e) = make_float2(c, s); }
      if (gt < 8) { float* misc = (float*)(ws + WS_MISC); misc[gt] = log1pf(-exp2f(-5.0f - (float)gt)) * 1.4426950408889634f; }
      if (vcu == 0 && wave == 1) {
          float* misc = (float*)(ws + WS_MISC);
          for (int j = 0; j < 2; ++j) { const float a = wave_sum(A.lam_q1[j * 64 + lane] * A.lam_k1[j * 64 + lane]), b2 = wave_sum(A.lam_q2[j * 64 + lane] * A.lam_k2[j * 64 + lane]);
              if (lane == 0) misc[16 + j] = expf(a) - expf(b2) + (j == 0 ? LAMBDA_INIT2 : LAMBDA_INIT3); } } }
    for (int m = gw; m < M; m += NGW) row_to_xn(A.x + (size_t)m * DM, (bf16*)(ws + WS_XN) + (size_t)m * DM, lane);
}

__device__ __forceinline__ void norm_phase(const float* Y, const float* base, const float* gpost, float* out, bf16* XN, bool write_xn, int gw, int NGW, int lane) {
    f32x4 gp[4];
#pragma unroll
    for (int j = 0; j < 4; ++j) gp[j] = ((const f32x4*)gpost)[lane + 64 * j];
    for (int m = gw; m < M; m += NGW) {
        const GAS f32x4* yr = (const GAS f32x4*)(Y + (size_t)m * DM) + lane; const GAS f32x4* br = (const GAS f32x4*)(base + (size_t)m * DM) + lane;
        f32x4 y[4], xb[4]; float s = 0.f;
#pragma unroll
        for (int j = 0; j < 4; ++j) { y[j] = yr[64 * j]; xb[j] = br[64 * j]; s += (y[j].x * y[j].x + y[j].y * y[j].y) + (y[j].z * y[j].z + y[j].w * y[j].w); }
        const float rstd = 1.f / sqrtf(wave_sum(s) * (1.f / DM) + EPS); float s2 = 0.f;
        GAS f32x4* orow = (GAS f32x4*)(out + (size_t)m * DM) + lane;
#pragma unroll
        for (int j = 0; j < 4; ++j) { xb[j] = xb[j] + y[j] * rstd * gp[j]; orow[64 * j] = xb[j]; s2 += (xb[j].x * xb[j].x + xb[j].y * xb[j].y) + (xb[j].z * xb[j].z + xb[j].w * xb[j].w); }
        if (write_xn) { const float r2 = 1.f / sqrtf(wave_sum(s2) * (1.f / DM) + EPS); GAS unsigned long long* o8 = (GAS unsigned long long*)(XN + (size_t)m * DM) + lane;
#pragma unroll
            for (int j = 0; j < 4; ++j) o8[64 * j] = (unsigned long long)pkbf(xb[j].x * r2, xb[j].y * r2) | ((unsigned long long)pkbf(xb[j].z * r2, xb[j].w * r2) << 32); }
    }
}

__device__ __forceinline__ void combine_phase(const bf16* O0, bf16* O1, const bf16* Gt, const float* gsub, float lam, float oml, int gw, int NGW, int lane) {
    float gs[16];
#pragma unroll
    for (int i = 0; i < 16; ++i) gs[i] = gsub[((lane & 7) * 16 + i)] * oml;
    for (int m = gw; m < M; m += NGW) {
        const size_t off = (size_t)m * DM + lane * 16;
        const v4u a0 = *(const GAS v4u*)(O0 + off), a1 = *(const GAS v4u*)(O0 + off + 8), b0 = *(const GAS v4u*)(O1 + off), b1 = *(const GAS v4u*)(O1 + off + 8), g0 = *(const GAS v4u*)(Gt + off), g1 = *(const GAS v4u*)(Gt + off + 8);
        float d[16], gg[16];
        const unsigned aw[8] = {a0.x, a0.y, a0.z, a0.w, a1.x, a1.y, a1.z, a1.w}, bw[8] = {b0.x, b0.y, b0.z, b0.w, b1.x, b1.y, b1.z, b1.w}, gw8[8] = {g0.x, g0.y, g0.z, g0.w, g1.x, g1.y, g1.z, g1.w};
        float ss = 0.f;
#pragma unroll
        for (int i = 0; i < 8; ++i) { d[2 * i] = pg8::bflo(aw[i]) - lam * pg8::bflo(bw[i]); d[2 * i + 1] = pg8::bfhi(aw[i]) - lam * pg8::bfhi(bw[i]); gg[2 * i] = pg8::bflo(gw8[i]); gg[2 * i + 1] = pg8::bfhi(gw8[i]);
            ss += d[2 * i] * d[2 * i] + d[2 * i + 1] * d[2 * i + 1]; }
        ss += __shfl_xor(ss, 1); ss += __shfl_xor(ss, 2); ss += __shfl_xor(ss, 4);
        const float rstd = 1.f / sqrtf(ss * (1.f / 128.f) + EPS);
        unsigned o[8];
#pragma unroll
        for (int i = 0; i < 8; ++i) o[i] = pkbf(d[2 * i] * rstd * gs[2 * i] * gg[2 * i], d[2 * i + 1] * rstd * gs[2 * i + 1] * gg[2 * i + 1]);
        *(GAS v4u*)(O1 + off) = (v4u){o[0], o[1], o[2], o[3]}; *(GAS v4u*)(O1 + off + 8) = (v4u){o[4], o[5], o[6], o[7]};
    }
}

constexpr int N_PHASES = 23;
#ifndef PHMASK
#define PHMASK 0xffff
#endif
#define PH_ON(k) ((SEL < 0 && ((PHMASK >> (k)) & 1)) || SEL == (k))
template <int SEL> __global__ void __launch_bounds__(NWAVES * 64, 2) mk_fwd(Args A) {
    extern __shared__ __attribute__((aligned(16))) unsigned char lds_raw[];
    LAS unsigned char* lds = (LAS unsigned char*)lds_raw;
    const int tid = threadIdx.x, lane = tid & 63, wave = __builtin_amdgcn_readfirstlane(tid >> 6);
    const int G = gridDim.x, bx = blockIdx.x, vcu = (G % 8 == 0) ? (bx % 8) * (G / 8) + bx / 8 : bx;
    const int gw = vcu * NWAVES + wave, NGW = G * NWAVES;
    gu32* ctl = (gu32*)(A.ws + WS_CTL);
    for (int u = tid; u < (LDS_BYTES - LDSCTL_OFF) / 4; u += NWAVES * 64) ((LAS unsigned*)(lds + LDSCTL_OFF))[u] = 0u;
    __syncthreads();
    XcdBarrier bar; bar.bar = (unsigned*)(ctl + CW_BAR); bar.x = 0; bar.st = nullptr;
    if (A.use_bar) bar = xcd_barrier_post((unsigned*)(ctl + CW_BAR), (volatile LAS unsigned*)(lds + MISC_OFF) + 8);

#define WSP(T, off) ((T*)(ws_ + (off)))
#define PH_BEGIN(k) if (A.ph_lo <= (k) && (k) < A.ph_hi) { int tid = threadIdx.x; asm volatile("" : "+v"(tid)); const int lane = tid & 63; unsigned char* ws_ = A.ws; asm volatile("" : "+s"(ws_)); (void)lane; (void)ws_;
#define PH_END(k) if (A.use_bar && (k) + 1 < A.ph_hi) xcd_barrier(bar); }
    const size_t MB1 = (size_t)M * 1024;
    PH_BEGIN(0) if (PH_ON(0)) p0_prologue(A, lds, vcu, G, wave, lane, tid); PH_END(0)
#pragma unroll 1
    for (int l = 0; l < 2; ++l) {
        const int pb = 1 + 6 * l;
        PH_BEGIN(pb + 0) if (PH_ON(1)) { pg8::Gemm g{WSP(bf16, WS_XN), WSP(bf16, WS_WINA) + (size_t)l * 6144 * 1024, M, 4096, 1024}; pg8::StaticOrder S; S.init(M, 4096, G, bx);
            pg8::EpiRet E{WSP(bf16, WS_R), WSP(bf16, WS_R) + MB1, WSP(bf16, WS_R) + 2 * MB1, WSP(float, WS_CS128), WSP(float, WS_MISC)};
            pg8::gemm_phase<pg8::EpiRet, pg8::StaticOrder, true, true>(lds + RING_OFF, g, S, E); } PH_END(pb + 0)
        PH_BEGIN(pb + 1) if (PH_ON(2)) { ret::Bufs B{WSP(bf16, WS_R), WSP(bf16, WS_R) + MB1, WSP(bf16, WS_R) + 2 * MB1, WSP(float, WS_L), WSP(float, WS_MISC)};
            for (int u = vcu; u < 256; u += G) if ((u & 15) != 15) ret::r1_unit(lds + RING_OFF, B, u); } PH_END(pb + 1)
        PH_BEGIN(pb + 2) if (PH_ON(3)) { ret::Bufs B{WSP(bf16, WS_R), WSP(bf16, WS_R) + MB1, WSP(bf16, WS_R) + 2 * MB1, WSP(float, WS_L), WSP(float, WS_MISC)};
            for (int u = vcu; u < 256; u += G) ret::r3_unit(lds + RING_OFF, B, u); } PH_END(pb + 2)
        PH_BEGIN(pb + 3) if (PH_ON(4)) { pg8::Gemm g{WSP(bf16, WS_XN), WSP(bf16, WS_WINA) + (size_t)l * 6144 * 1024 + (size_t)4096 * 1024, M, 2048, 1024}; pg8::StaticOrder S; S.init(M, 2048, G, bx);
            pg8::EpiGate E{WSP(bf16, WS_R) + 2 * MB1};
            pg8::gemm_phase<pg8::EpiGate, pg8::StaticOrder, true, true>(lds + RING_OFF, g, S, E); } PH_END(pb + 3)
        PH_BEGIN(pb + 4) if (PH_ON(5)) { pg8::Gemm g{WSP(bf16, WS_R) + 2 * MB1, WSP(bf16, WS_WOUTA) + (size_t)l * 1024 * 2048, M, 1024, 2048}; pg8::StaticOrder S; S.init(M, 1024, G, bx);
            pg8::EpiY E{WSP(float, WS_R), 1024};
            pg8::gemm_phase<pg8::EpiY, pg8::StaticOrder, true, true>(lds + RING_OFF, g, S, E); } PH_END(pb + 4)
        PH_BEGIN(pb + 5) if (PH_ON(6)) norm_phase(WSP(float, WS_R), l == 0 ? A.x : A.out, A.post_norm + l * 1024, A.out, WSP(bf16, WS_XN), true, gw, NGW, lane); PH_END(pb + 5)
    }
#pragma unroll 1
    for (int j = 0; j < 2; ++j) {
        const int pb = 13 + 5 * j;
        PH_BEGIN(pb + 0) if (PH_ON(7)) { pg8::Gemm g{WSP(bf16, WS_XN), j == 0 ? WSP(bf16, WS_WKVQ) : WSP(bf16, WS_W3), M, j == 0 ? 4096 : 2048, 1024}; pg8::StaticOrder S; S.init(M, g.N, G, bx);
            pg8::EpiDiff E{WSP(bf16, WS_R), WSP(bf16, WS_R) + MB1, WSP(bf16, WS_R) + 2 * MB1, WSP(bf16, WS_R) + 3 * MB1, WSP(float, WS_CS64), j == 0 ? 0 : 8, C2};
            pg8::gemm_phase<pg8::EpiDiff, pg8::StaticOrder, true, true>(lds + RING_OFF, g, S, E); } PH_END(pb + 0)
        PH_BEGIN(pb + 1) if (PH_ON(8)) { const attn_body::AttnTensors AT{WSP(const attn_body::bf16, WS_R) + 2 * MB1, WSP(const attn_body::bf16, WS_R), WSP(const attn_body::bf16, WS_R) + MB1, WSP(attn_body::bf16, WS_XN), WSP(attn_body::bf16, WS_L)};
            const attn_body::StaticOrder S(G, bx);
            attn_body::attn_phase<attn_body::StaticOrder>((char*)lds_raw + RING_OFF, AT, S); } PH_END(pb + 1)
        PH_BEGIN(pb + 2) if (PH_ON(9)) combine_phase(WSP(bf16, WS_XN), WSP(bf16, WS_L), WSP(bf16, WS_R) + 3 * MB1, A.sub_norm_b + j * 128, WSP(float, WS_MISC)[16 + j], 1.0f - (j == 0 ? LAMBDA_INIT2 : LAMBDA_INIT3), gw, NGW, lane); PH_END(pb + 2)
        PH_BEGIN(pb + 3) if (PH_ON(10)) { pg8::Gemm g{WSP(bf16, WS_L), WSP(bf16, WS_WOUTB) + (size_t)j * 1024 * 1024, M, 1024, 1024}; pg8::StaticOrder S; S.init(M, 1024, G, bx);
            pg8::EpiY E{WSP(float, WS_R + 64 * MiB), 1024};
            pg8::gemm_phase<pg8::EpiY, pg8::StaticOrder, true, true>(lds + RING_OFF, g, S, E); } PH_END(pb + 3)
        PH_BEGIN(pb + 4) if (PH_ON(6)) norm_phase(WSP(float, WS_R + 64 * MiB), A.out, A.post_norm + (2 + j) * 1024, A.out, WSP(bf16, WS_XN), j == 0, gw, NGW, lane); PH_END(pb + 4)
    }
}

#ifndef MK_FUSED
#define MK_FUSED 1
#endif
#if !MK_FUSED
typedef void (*kern_t)(Args);
static int phase_sel(int ph) {
    if (ph == 0) return 0;
    if (ph <= 12) return 1 + (ph - 1) % 6;
    const int k = (ph - 13) % 5; return k == 4 ? 6 : 7 + k;
}
static kern_t sel_kernel(int sel) {
    switch (sel) { case 0: return mk_fwd<0>; case 1: return mk_fwd<1>; case 2: return mk_fwd<2>; case 3: return mk_fwd<3>; case 4: return mk_fwd<4>; case 5: return mk_fwd<5>;
                   case 6: return mk_fwd<6>; case 7: return mk_fwd<7>; case 8: return mk_fwd<8>; case 9: return mk_fwd<9>; default: return mk_fwd<10>; }
}
#endif
extern "C" void kernel_launch(void* const* d_in, const int* in_sizes, int n_in, void* d_out, int out_size, void* d_ws, size_t ws_size, hipStream_t stream) {
    static int grid = 0;
    if (grid == 0) {
        if (n_in != 14 || out_size != M * DM || ws_size < WS_END) { fprintf(stderr, "kernel_launch: unexpected shapes (n_in %d out %d ws %zu)\n", n_in, out_size, ws_size); grid = -1; return; }
        int dev = 0, cus = 0;
        if (hipGetDevice(&dev) != hipSuccess || hipDeviceGetAttribute(&cus, hipDeviceAttributeMultiprocessorCount, dev) != hipSuccess) { grid = -1; return; }
#if MK_FUSED
        if (hipFuncSetAttribute((const void*)mk_fwd<-1>, hipFuncAttributeMaxDynamicSharedMemorySize, LDS_BYTES) != hipSuccess) { fprintf(stderr, "kernel_launch: hipFuncSetAttribute failed\n"); grid = -1; return; }
#else
        for (int k = 0; k <= 10; ++k) if (hipFuncSetAttribute((const void*)sel_kernel(k), hipFuncAttributeMaxDynamicSharedMemorySize, LDS_BYTES) != hipSuccess) { fprintf(stderr, "kernel_launch: hipFuncSetAttribute failed\n"); grid = -1; return; }
#endif
        (void)hipGetLastError();
        grid = cus;
    }
    if (grid < 0) return;
    (void)hipMemsetAsync((char*)d_ws + WS_CTL, 0, CTL_ZERO_BYTES, stream);
    Args a{};
    a.x = (const float*)d_in[0]; a.pre_norm = (const float*)d_in[1]; a.post_norm = (const float*)d_in[2]; a.w_in_a = (const float*)d_in[3]; a.w_out_a = (const float*)d_in[4];
    a.kv_norm = (const float*)d_in[5]; a.w_kv = (const float*)d_in[6]; a.w_in_b = (const float*)d_in[7]; a.lam_q1 = (const float*)d_in[8]; a.lam_k1 = (const float*)d_in[9];
    a.lam_q2 = (const float*)d_in[10]; a.lam_k2 = (const float*)d_in[11]; a.sub_norm_b = (const float*)d_in[12]; a.w_out_b = (const float*)d_in[13];
    a.out = (float*)d_out; a.ws = (unsigned char*)d_ws;
#if MK_FUSED
    a.ph_lo = 0; a.ph_hi = N_PHASES; a.use_bar = 1;
    hipLaunchKernelGGL(mk_fwd<-1>, dim3(grid), dim3(NWAVES * 64), LDS_BYTES, stream, a);
#else
    for (int ph = 0; ph < N_PHASES; ++ph) { a.ph_lo = ph; a.ph_hi = ph + 1; a.use_bar = 0; hipLaunchKernelGGL(sel_kernel(phase_sel(ph)), dim3(grid), dim3(NWAVES * 64), LDS_BYTES, stream, a); }
#endif
}
```

```cpp
#include <hip/hip_runtime.h>
#include <hip/hip_bf16.h>
#include <cstdio>
#include <cstdint>
#include <cmath>
namespace pg8 {
#define PG8_LAS __attribute__((address_space(3)))
typedef unsigned short bf16_t;
typedef short bf16x8 __attribute__((ext_vector_type(8)));
typedef float f32x4 __attribute__((ext_vector_type(4)));
typedef unsigned u32x4 __attribute__((ext_vector_type(4)));
constexpr int BM = 256, BK = 64, HALF = 128, HTB = HALF * BK * 2  , STAGE_BYTES = 8 * HTB, NXCD = 8, WGM = 8;

__host__ __device__ __forceinline__ int lds_byte(int r, int c) { const int st = (r >> 4) * 2 + (c >> 5), rr = r & 15, cc = c & 31, ob = rr * 64 + cc * 2; return st * 1024 + (ob ^ (((ob >> 9) & 1) << 5)); }
__host__ __device__ __forceinline__ void stage_rc(int b, int& R, int& C) { const int st = b / 1024, sb = b % 1024, swz = sb ^ (((sb >> 9) & 1) << 5); R = (st >> 1) * 16 + swz / 64; C = (st & 1) * 32 + (swz % 64) / 2; }
__host__ __device__ __forceinline__ int perm32(int rho) { const int n = rho >> 4, i = rho & 15; return 8 * (i >> 2) + 4 * n + (i & 3); }

struct Unit { int pm, pn; };
struct Gemm { const bf16_t* A; const bf16_t* Bt; int M, N, K; };

struct StaticOrder {
    int nM, nN, nwg, G, c;
    __host__ __device__ void init(int M, int N, int G_, int c_) { nM = M / BM; nN = N / BM; nwg = nM * nN; G = G_; c = c_; }
    __host__ __device__ bool next(int i, Unit& u) const {
        const long L = (long)i * G + c; if (L >= nwg) return false;
        int wgid = (int)L; { const int q = nwg / NXCD, r = nwg % NXCD, xcd = wgid % NXCD, off = wgid / NXCD; wgid = (xcd < r ? xcd * (q + 1) : r * (q + 1) + (xcd - r) * q) + off; }
        const int nig = WGM * nN, gid = wgid / nig, fm = gid * WGM, gsz = (nM - fm) < WGM ? (nM - fm) : WGM;
        u.pm = fm + ((wgid % nig) % gsz); u.pn = (wgid % nig) / gsz; return true;
    }
    __device__ __forceinline__ void a_ready(const Unit&) const {}
    __device__ __forceinline__ void done(const Unit&) const {}
};

__device__ __forceinline__ unsigned cvt_pk_bf16(float lo, float hi) { unsigned r; asm volatile("v_cvt_pk_bf16_f32 %0, %1, %2" : "=v"(r) : "v"(lo), "v"(hi)); return r; }
typedef float f32x2 __attribute__((ext_vector_type(2)));
__device__ __forceinline__ f32x2 gelu_pk(f32x2 v) {
    const f32x2 av = __builtin_elementwise_abs(v), d = av * 0.2316418882f + 1.0f;
    f32x2 t; t.x = __builtin_amdgcn_rcpf(d.x); t.y = __builtin_amdgcn_rcpf(d.y);
    f32x2 q = t * 0.5307027145f + (-0.7265760135f); q = q * t + 0.7107068705f; q = q * t + (-0.142248368f); q = q * t + 0.127414796f; q = q * t;
    const f32x2 s = (v * v) * (-0.72134752044f);
    f32x2 e; e.x = __builtin_amdgcn_exp2f(s.x); e.y = __builtin_amdgcn_exp2f(s.y);
    const f32x2 m = v * (q * e), r = v - m;
    f32x2 o; o.x = v.x < 0.f ? m.x : r.x; o.y = v.y < 0.f ? m.y : r.y; return o;
}

template <int ACT  > struct EpiBf16 {
    static constexpr bool PERM = true, AFTER_DRAIN = false; static_assert(ACT == 0 || ACT == 1, "EpiBf16: ACT is 0 (none) or 1 (gelu_pk)");
    bf16_t* O; int ldc; const float* bias; int split_cols; size_t split_stride; float scale0;
    __device__ __forceinline__ void operator()(const f32x4 (&acc)[2][2][4][2], const Unit& u, int wr, int wc, int fr, int fq) const {
        const int row0 = u.pm * BM + wr * 64 + fr; int colt = u.pn * BM; bf16_t* base = O;
        float sc = 1.f; if (split_cols) { const int t = colt / split_cols; base += (size_t)t * split_stride; colt -= t * split_cols; if (t == 0) sc = scale0; }
        const int col0 = colt + wc * 32 + 8 * fq, bcol0 = u.pn * BM + wc * 32 + 8 * fq;
        f32x4 bv[2][2];
#pragma unroll
        for (int bj = 0; bj < 2; ++bj)
#pragma unroll
            for (int n = 0; n < 2; ++n) bv[bj][n] = bias ? *(const f32x4*)(bias + bcol0 + bj * HALF + 4 * n) : (f32x4){0.f, 0.f, 0.f, 0.f};
#pragma unroll
        for (int ai = 0; ai < 2; ++ai)
#pragma unroll
            for (int m = 0; m < 4; ++m) { bf16_t* rowp = base + (size_t)(row0 + ai * HALF + m * 16) * ldc + col0;
#pragma unroll
                for (int bj = 0; bj < 2; ++bj) { f32x4 v0 = acc[ai][bj][m][0] + bv[bj][0], v1 = acc[ai][bj][m][1] + bv[bj][1];
                    if (ACT == 1) { f32x2 a = gelu_pk((f32x2){v0[0], v0[1]}), b = gelu_pk((f32x2){v0[2], v0[3]}), c = gelu_pk((f32x2){v1[0], v1[1]}), d = gelu_pk((f32x2){v1[2], v1[3]});
                        v0 = (f32x4){a.x, a.y, b.x, b.y}; v1 = (f32x4){c.x, c.y, d.x, d.y}; }
                    v0 = v0 * sc; v1 = v1 * sc; u32x4 w; w.x = cvt_pk_bf16(v0[0], v0[1]); w.y = cvt_pk_bf16(v0[2], v0[3]); w.z = cvt_pk_bf16(v1[0], v1[1]); w.w = cvt_pk_bf16(v1[2], v1[3]);
                    *(u32x4*)(rowp + bj * HALF) = w; } }
    }
};
typedef __bf16 bf16x2_t __attribute__((ext_vector_type(2)));
__device__ __forceinline__ unsigned pkbf(float lo, float hi) { f32x2 v = {lo, hi}; bf16x2_t b = __builtin_convertvector(v, bf16x2_t); return __builtin_bit_cast(unsigned, b); }
__device__ __forceinline__ float bflo(unsigned u) { return __builtin_bit_cast(float, u << 16); }
__device__ __forceinline__ float bfhi(unsigned u) { return __builtin_bit_cast(float, u & 0xffff0000u); }
__device__ __forceinline__ float silu_f(float x) { return x * __builtin_amdgcn_rcpf(1.0f + __builtin_amdgcn_exp2f(-1.4426950408889634f * x)); }
__device__ __forceinline__ void rope8(f32x4& v0, f32x4& v1, const float* cs, float sc) {
    const f32x4 t0 = *(const f32x4*)cs, t1 = *(const f32x4*)(cs + 4);
    f32x4 o0, o1;
    o0[0] = (v0[0] * t0[0] - v0[1] * t0[1]) * sc; o0[1] = (v0[0] * t0[1] + v0[1] * t0[0]) * sc;
    o0[2] = (v0[2] * t0[2] - v0[3] * t0[3]) * sc; o0[3] = (v0[2] * t0[3] + v0[3] * t0[2]) * sc;
    o1[0] = (v1[0] * t1[0] - v1[1] * t1[1]) * sc; o1[1] = (v1[0] * t1[1] + v1[1] * t1[0]) * sc;
    o1[2] = (v1[2] * t1[2] - v1[3] * t1[3]) * sc; o1[3] = (v1[2] * t1[3] + v1[3] * t1[2]) * sc;
    v0 = o0; v1 = o1;
}
__device__ __forceinline__ u32x4 pack8(const f32x4& v0, const f32x4& v1) { u32x4 w; w.x = pkbf(v0[0], v0[1]); w.y = pkbf(v0[2], v0[3]); w.z = pkbf(v1[0], v1[1]); w.w = pkbf(v1[2], v1[3]); return w; }

struct EpiRet {
    static constexpr bool PERM = true, AFTER_DRAIN = false;
    bf16_t* Q; bf16_t* KD; bf16_t* V; const float* cs128; const float* lgtab;
    __device__ __forceinline__ void operator()(const f32x4 (&acc)[2][2][4][2], const Unit& u, int wr, int wc, int fr, int fq) const {
        const int row0 = u.pm * BM + wr * 64 + fr, pb = wc * 32 + 8 * fq;
        if (u.pn < 8) {
            const bool isk = u.pn >= 4; bf16_t* base = (isk ? KD : Q) + (u.pn & 3) * 256 + pb;
            float lg[2] = {0.f, 0.f}; if (isk) { lg[0] = lgtab[(u.pn - 4) * 2]; lg[1] = lgtab[(u.pn - 4) * 2 + 1]; }
#pragma unroll
            for (int ai = 0; ai < 2; ++ai)
#pragma unroll
                for (int m = 0; m < 4; ++m) { const int row = row0 + ai * HALF + m * 16, pos = row & 8191; const float* cs = cs128 + ((size_t)pos * 64 + (pb >> 1)) * 2;
#pragma unroll
                    for (int bj = 0; bj < 2; ++bj) { float sc = 1.f; if (isk) sc = 0.08838834764831845f * __builtin_amdgcn_exp2f((float)(63 - (pos & 63)) * lg[bj]);
                        f32x4 v0 = acc[ai][bj][m][0], v1 = acc[ai][bj][m][1]; rope8(v0, v1, cs, sc);
                        *(u32x4*)(base + (size_t)row * 1024 + bj * HALF) = pack8(v0, v1); }
                    asm volatile("" ::: "memory"); }
        } else {
            bf16_t* base = V + (u.pn - 8) * 256 + pb;
#pragma unroll
            for (int ai = 0; ai < 2; ++ai)
#pragma unroll
                for (int m = 0; m < 4; ++m) { const int row = row0 + ai * HALF + m * 16;
#pragma unroll
                    for (int bj = 0; bj < 2; ++bj) *(u32x4*)(base + (size_t)row * 2048 + bj * HALF) = pack8(acc[ai][bj][m][0], acc[ai][bj][m][1]); }
        }
    }
};
struct EpiGate {
    static constexpr bool PERM = true, AFTER_DRAIN = false;
    bf16_t* On;
    __device__ __forceinline__ void operator()(const f32x4 (&acc)[2][2][4][2], const Unit& u, int wr, int wc, int fr, int fq) const {
        const int row0 = u.pm * BM + wr * 64 + fr; bf16_t* base = On + u.pn * 256 + wc * 32 + 8 * fq;
#pragma unroll
        for (int ai = 0; ai < 2; ++ai)
#pragma unroll
            for (int m = 0; m < 4; ++m) { const int row = row0 + ai * HALF + m * 16;
#pragma unroll
                for (int bj = 0; bj < 2; ++bj) { u32x4* p = (u32x4*)(base + (size_t)row * 2048 + bj * HALF); const u32x4 o = *p; const f32x4 g0 = acc[ai][bj][m][0], g1 = acc[ai][bj][m][1];
                    f32x4 v0, v1; v0[0] = bflo(o.x) * silu_f(g0[0]); v0[1] = bfhi(o.x) * silu_f(g0[1]); v0[2] = bflo(o.y) * silu_f(g0[2]); v0[3] = bfhi(o.y) * silu_f(g0[3]);
                    v1[0] = bflo(o.z) * silu_f(g1[0]); v1[1] = bfhi(o.z) * silu_f(g1[1]); v1[2] = bflo(o.w) * silu_f(g1[2]); v1[3] = bfhi(o.w) * silu_f(g1[3]);
                    *p = pack8(v0, v1); }
                asm volatile("" ::: "memory"); }
    }
};
struct EpiY {
    static constexpr bool PERM = false, AFTER_DRAIN = false;
    float* Y; int ldc;
    __device__ __forceinline__ void operator()(const f32x4 (&acc)[2][2][4][2], const Unit& u, int wr, int wc, int fr, int fq) const {
        const int row0 = u.pm * BM + wr * 64 + fr; float* base = Y + u.pn * 256 + wc * 32 + 4 * fq;
#pragma unroll
        for (int ai = 0; ai < 2; ++ai)
#pragma unroll
            for (int m = 0; m < 4; ++m) { float* rp = base + (size_t)(row0 + ai * HALF + m * 16) * ldc;
#pragma unroll
                for (int bj = 0; bj < 2; ++bj)
#pragma unroll
                    for (int n = 0; n < 2; ++n) *(f32x4*)(rp + bj * HALF + n * 16) = acc[ai][bj][m][n]; }
    }
};
struct EpiDiff {
    static constexpr bool PERM = true, AFTER_DRAIN = false;
    bf16_t* KS; bf16_t* VS; bf16_t* Q2; bf16_t* G; const float* cs64; int pn_off; float qscale;
    __device__ __forceinline__ void operator()(const f32x4 (&acc)[2][2][4][2], const Unit& u, int wr, int wc, int fr, int fq) const {
        const int row0 = u.pm * BM + wr * 64 + fr, pb = wc * 32 + 8 * fq, t = u.pn + pn_off, ty = t >> 2;
        bf16_t* base = (ty == 0 ? KS : ty == 1 ? VS : ty == 2 ? Q2 : G) + (t & 3) * 256 + pb;
        const float sc = (ty == 2) ? qscale : 1.f;
#pragma unroll
        for (int ai = 0; ai < 2; ++ai)
#pragma unroll
            for (int m = 0; m < 4; ++m) { const int row = row0 + ai * HALF + m * 16, pos = row & 8191; const float* cs = cs64 + ((size_t)pos * 32 + ((pb & 63) >> 1)) * 2;
#pragma unroll
                for (int bj = 0; bj < 2; ++bj) { f32x4 v0 = acc[ai][bj][m][0], v1 = acc[ai][bj][m][1];
                    if (ty == 0 || ty == 2) rope8(v0, v1, cs, sc);
                    else if (ty == 3) {
#pragma unroll
                        for (int e = 0; e < 4; ++e) { v0[e] = silu_f(v0[e]); v1[e] = silu_f(v1[e]); } }
                    *(u32x4*)(base + (size_t)row * 1024 + bj * HALF) = pack8(v0, v1); }
                asm volatile("" ::: "memory"); }
    }
};
template <class Epi, class Sched, bool ALIGN_EPI = false, bool SP2 = false>
__device__ __forceinline__ void gemm_phase(PG8_LAS unsigned char* lds, const Gemm g, const Sched& S, const Epi& E) {
    int tid_o = threadIdx.x; asm volatile("" : "+v"(tid_o));
    const int tid = tid_o, wid = __builtin_amdgcn_readfirstlane(tid >> 6), lane = tid & 63, wr = wid >> 2, wc = wid & 3, fr = lane & 15, fq = lane >> 4;
    const int K = g.K, nt = K / BK;
    unsigned voffA[2], voffB[2];
#pragma unroll
    for (int i = 0; i < 2; ++i) { int R, C; stage_rc(tid * 16 + i * 8192, R, C); const int Rb = Epi::PERM ? ((R & ~31) + perm32(R & 31)) : R;
        voffA[i] = (unsigned)(R * K + C) * 2u; voffB[i] = (unsigned)(Rb * K + C) * 2u; }
    const size_t kstep = (size_t)(BK * 2);
    const size_t hstep = (size_t)HALF * K * 2;
    const size_t tstep = 2 * hstep;
    const unsigned ldsw = (unsigned)wid * 1024u;
    const int aoff = lds_byte(wr * 64 + fr, fq * 8), boff = lds_byte(wc * 32 + fr, fq * 8);
#define PG8_SA(b, h) (((b) * 2 + (h)) * HTB)
#define PG8_SB(b, h) ((4 + (b) * 2 + (h)) * HTB)
#define PG8_STAGE(bufoff, gbase, voff) do { _Pragma("unroll") for (int _i = 0; _i < 2; ++_i) \
        __builtin_amdgcn_global_load_lds((const unsigned*)((const char*)(gbase) + (voff)[_i]), (PG8_LAS unsigned*)(lds + (bufoff) + ldsw + _i * 8192), 16, 0, 0); } while (0)
#define PG8_LDA(dst, b, h) do { _Pragma("unroll") for (int m = 0; m < 4; ++m) _Pragma("unroll") for (int k = 0; k < 2; ++k) dst[m][k] = *(const PG8_LAS bf16x8*)(lds + PG8_SA(b, h) + aoff + m * 2048 + k * 1024); } while (0)
#define PG8_LDB(dst, b, h) do { _Pragma("unroll") for (int n = 0; n < 2; ++n) _Pragma("unroll") for (int k = 0; k < 2; ++k) dst[n][k] = *(const PG8_LAS bf16x8*)(lds + PG8_SB(b, h) + boff + n * 2048 + k * 1024); } while (0)
#define PG8_MMA(ai, bj, At, Bt) do { __builtin_amdgcn_s_setprio(1); _Pragma("unroll") for (int m = 0; m < 4; ++m) _Pragma("unroll") for (int n = 0; n < 2; ++n) _Pragma("unroll") for (int k = 0; k < 2; ++k) \
        acc[ai][bj][m][n] = __builtin_amdgcn_mfma_f32_16x16x32_bf16(Bt[n][k], At[m][k], acc[ai][bj][m][n], 0, 0, 0); __builtin_amdgcn_s_setprio(0); } while (0)
#define PG8_WAIT_V(n) asm volatile("s_waitcnt vmcnt(" #n ")" ::: "memory")
#define PG8_WAIT_L(n) asm volatile("s_waitcnt lgkmcnt(" #n ")" ::: "memory")
#define PG8_BAR __builtin_amdgcn_s_barrier()
#define PG8_SCHED __builtin_amdgcn_sched_barrier(0)
    Unit cur, nxt; int ui = 0;
    if (!S.next(0, cur)) return;
    f32x4 acc[2][2][4][2];
#pragma unroll
    for (int a = 0; a < 2; ++a)
#pragma unroll
        for (int b = 0; b < 2; ++b)
#pragma unroll
            for (int m = 0; m < 4; ++m)
#pragma unroll
                for (int n = 0; n < 2; ++n) acc[a][b][m][n] = (f32x4){0.f, 0.f, 0.f, 0.f};
    bf16x8 At[4][2], B0[2][2], B1[2][2];
    const char* cA = (const char*)g.A + (size_t)cur.pm * tstep; const char* cB = (const char*)g.Bt + (size_t)cur.pn * tstep;
    S.a_ready(cur);
    if constexpr (SP2) {
        PG8_STAGE(PG8_SB(0, 0), cB, voffB); PG8_STAGE(PG8_SB(0, 1), cB + hstep, voffB); PG8_STAGE(PG8_SA(0, 0), cA, voffA); PG8_STAGE(PG8_SA(0, 1), cA + hstep, voffA);
        if (wr == 1) PG8_BAR;
        PG8_WAIT_V(2); PG8_BAR;
        PG8_STAGE(PG8_SB(1, 0), cB + kstep, voffB); PG8_STAGE(PG8_SA(1, 0), cA + kstep, voffA); PG8_STAGE(PG8_SB(1, 1), cB + hstep + kstep, voffB);
        PG8_WAIT_V(6); PG8_BAR;
    } else {
        PG8_STAGE(PG8_SB(0, 0), cB, voffB); PG8_STAGE(PG8_SA(0, 0), cA, voffA); PG8_STAGE(PG8_SB(0, 1), cB + hstep, voffB); PG8_STAGE(PG8_SA(0, 1), cA + hstep, voffA);
        if (wr == 1) PG8_BAR;
        PG8_WAIT_V(4); PG8_BAR;
        PG8_STAGE(PG8_SB(1, 0), cB + kstep, voffB); PG8_STAGE(PG8_SA(1, 0), cA + kstep, voffA); PG8_STAGE(PG8_SB(1, 1), cB + hstep + kstep, voffB);
        PG8_WAIT_V(6); PG8_BAR;
    }
    for (;;) {
        const bool has_next = S.next(ui + 1, nxt);
        const char* nA = has_next ? (const char*)g.A + (size_t)nxt.pm * tstep : cA; const char* nB = has_next ? (const char*)g.Bt + (size_t)nxt.pn * tstep : cB;
        for (int t = 0; t < nt; t += 2) {
            const bool last = (t == nt - 2);
            const char* a1 = cA + (size_t)(t + 1) * kstep;
            const char* a2 = last ? nA : cA + (size_t)(t + 2) * kstep; const char* b2 = last ? nB : cB + (size_t)(t + 2) * kstep;
            const char* a3 = a2 + kstep; const char* b3 = b2 + kstep;
            if (last && has_next) S.a_ready(nxt);
            if constexpr (SP2) {
            PG8_LDB(B0, 0, 0); PG8_LDB(B1, 0, 1); PG8_SCHED; PG8_LDA(At, 0, 0); PG8_STAGE(PG8_SA(1, 1), a1 + hstep, voffA);
            PG8_WAIT_V(8); PG8_WAIT_L(0); PG8_BAR; PG8_MMA(0, 0, At, B0); PG8_MMA(0, 1, At, B1); PG8_BAR; PG8_SCHED;
            PG8_LDA(At, 0, 1); PG8_STAGE(PG8_SB(0, 0), b2, voffB); PG8_STAGE(PG8_SB(0, 1), b2 + hstep, voffB); PG8_STAGE(PG8_SA(0, 0), a2, voffA);
            PG8_WAIT_V(8); PG8_WAIT_L(0); PG8_BAR; PG8_MMA(1, 0, At, B0); PG8_MMA(1, 1, At, B1); PG8_BAR; PG8_SCHED;
            PG8_LDB(B0, 1, 0); PG8_LDB(B1, 1, 1); PG8_SCHED; PG8_LDA(At, 1, 0); PG8_STAGE(PG8_SA(0, 1), a2 + hstep, voffA);
            PG8_WAIT_V(8); PG8_WAIT_L(0); PG8_BAR; PG8_MMA(0, 0, At, B0); PG8_MMA(0, 1, At, B1); PG8_BAR; PG8_SCHED;
            PG8_LDA(At, 1, 1); PG8_STAGE(PG8_SB(1, 0), b3, voffB); PG8_STAGE(PG8_SB(1, 1), b3 + hstep, voffB); PG8_STAGE(PG8_SA(1, 0), a3, voffA);
            PG8_WAIT_V(8); PG8_WAIT_L(0); PG8_BAR; PG8_MMA(1, 0, At, B0); PG8_MMA(1, 1, At, B1); PG8_BAR; PG8_SCHED;
            } else {
            PG8_LDB(B0, 0, 0); PG8_SCHED; PG8_LDA(At, 0, 0); PG8_STAGE(PG8_SA(1, 1), a1 + hstep, voffA);
            PG8_WAIT_L(8); PG8_BAR; PG8_WAIT_L(0); PG8_MMA(0, 0, At, B0); PG8_BAR; PG8_SCHED;
            PG8_LDB(B1, 0, 1); PG8_STAGE(PG8_SB(0, 0), b2, voffB);
            PG8_BAR; PG8_WAIT_L(0); PG8_MMA(0, 1, At, B1); PG8_BAR;
            PG8_LDA(At, 0, 1); PG8_STAGE(PG8_SA(0, 0), a2, voffA);
            PG8_BAR; PG8_WAIT_L(0); PG8_MMA(1, 0, At, B0); PG8_BAR; PG8_SCHED;
            PG8_STAGE(PG8_SB(0, 1), b2 + hstep, voffB);
            PG8_WAIT_V(6); PG8_BAR; PG8_MMA(1, 1, At, B1); PG8_BAR;
            PG8_LDB(B0, 1, 0); PG8_SCHED; PG8_LDA(At, 1, 0); PG8_STAGE(PG8_SA(0, 1), a2 + hstep, voffA);
            PG8_WAIT_L(8); PG8_BAR; PG8_WAIT_L(0); PG8_MMA(0, 0, At, B0); PG8_BAR; PG8_SCHED;
            PG8_LDB(B1, 1, 1); PG8_STAGE(PG8_SB(1, 0), b3, voffB);
            PG8_BAR; PG8_WAIT_L(0); PG8_MMA(0, 1, At, B1); PG8_BAR;
            PG8_LDA(At, 1, 1); PG8_STAGE(PG8_SA(1, 0), a3, voffA);
            PG8_BAR; PG8_WAIT_L(0); PG8_MMA(1, 0, At, B0); PG8_BAR; PG8_SCHED;
            PG8_STAGE(PG8_SB(1, 1), b3 + hstep, voffB);
            PG8_WAIT_V(6); PG8_BAR; PG8_MMA(1, 1, At, B1); PG8_BAR;
            }
        }
        if constexpr (ALIGN_EPI) { if (wr == 0) PG8_BAR; }
        if constexpr (!Epi::AFTER_DRAIN) { E(acc, cur, wr, wc, fr, fq); S.done(cur); }
        if (!has_next) break;
#pragma unroll
        for (int a = 0; a < 2; ++a)
#pragma unroll
            for (int b = 0; b < 2; ++b)
#pragma unroll
                for (int m = 0; m < 4; ++m)
#pragma unroll
                    for (int n = 0; n < 2; ++n) acc[a][b][m][n] = (f32x4){0.f, 0.f, 0.f, 0.f};
        cur = nxt; cA = nA; cB = nB; ++ui;
        if constexpr (ALIGN_EPI) { if (wr == 1) PG8_BAR; }
    }
    PG8_WAIT_V(0);
    if constexpr (!ALIGN_EPI) { if (wr == 0) PG8_BAR; }
    PG8_BAR;
    if constexpr (Epi::AFTER_DRAIN) { E.fused(acc, cur, wr, wc, fr, fq, lds, wid, lane); S.done(cur); }
#undef PG8_SA
#undef PG8_SB
#undef PG8_STAGE
#undef PG8_LDA
#undef PG8_LDB
#undef PG8_MMA
#undef PG8_WAIT_V
#undef PG8_WAIT_L
#undef PG8_BAR
#undef PG8_SCHED
}
}
namespace attn_body {
using bf16=__hip_bfloat16;
using bf16x8=__attribute__((ext_vector_type(8)))short;
using s16x4=__attribute__((ext_vector_type(4)))short;
using f32x16=__attribute__((ext_vector_type(16)))float;
using u32x4=__attribute__((ext_vector_type(4)))unsigned;
constexpr int BATCH=2,NHEAD=16,SEQ=8192,D=64,DM=NHEAD*D;
constexpr int NW=8,QBLK=32,QB=QBLK*NW,KVBLK=64,NQB=SEQ/QB;
constexpr int ATTN_PITCH=DM, ATTN_UNIT_ROWS=QB;
__device__ __forceinline__ int crow(int r,int hi){return (r&3)+8*(r>>2)+4*hi;}
#define SBAR() __builtin_amdgcn_sched_barrier(0)
__device__ __forceinline__ void cmask(f32x16&p0,f32x16&p1,int jb,int qrel,int hi){
  const float NEG=-INFINITY; (void)hi;
  if(jb>(qrel>>6)){
  #pragma unroll
  for(int r=0;r<16;++r){p0[r]=NEG;p1[r]=NEG;} }
}

constexpr int NSLOT=3, SLOTB=8192;
constexpr int LDS_K=0, LDS_V=NSLOT*SLOTB, LDS_WS=3*NSLOT*SLOTB, LDS_OST=LDS_WS+NW*64*4, LDS_BYTES=LDS_OST+NW*8192;
constexpr float C2=0.125f*1.4426950408889634f;
__device__ __forceinline__ void glds16(const void*gsrc,unsigned lds_dst){unsigned keep;
  asm volatile("s_mov_b32 %0, m0\n\ts_mov_b32 m0, %2\n\ts_nop 0\n\tglobal_load_lds_dwordx4 %1, off\n\ts_mov_b32 m0, %0":"=&s"(keep):"v"(gsrc),"s"(lds_dst):"memory");}
__device__ __forceinline__ float max3f(float a,float b,float c){float r;asm("v_max3_f32 %0, %1, %2, %3":"=v"(r):"v"(a),"v"(b),"v"(c));return r;}
__device__ __forceinline__ float max2f(float a,float b){float r;asm("v_max_f32_e32 %0, %1, %2":"=v"(r):"v"(a),"v"(b));return r;}
__device__ __forceinline__ float fadd_s(float a,float b){float r;asm("v_add_f32_e32 %0, %1, %2":"=v"(r):"v"(a),"v"(b));return r;}
__device__ __forceinline__ float fsub_s(float a,float b){float r;asm("v_sub_f32_e32 %0, %1, %2":"=v"(r):"v"(a),"v"(b));return r;}
typedef float f32x2_t __attribute__((ext_vector_type(2))); typedef __bf16 bf16x2_t __attribute__((ext_vector_type(2)));
__device__ __forceinline__ unsigned cvtpk_s(float lo,float hi){f32x2_t v={lo,hi};bf16x2_t b=__builtin_convertvector(v,bf16x2_t);return __builtin_bit_cast(unsigned,b);}
#define WAIT_BAR(N) asm volatile("s_waitcnt vmcnt(" #N ") lgkmcnt(0)\n\ts_barrier":::"memory")

__device__ __forceinline__ void qkt(f32x16&p0,f32x16&p1,const char*Kslot,const bf16x8*qr,int r32,int hi){ const f32x16 negm=f32x16{};
  const char*kb=Kslot+hi*1024+r32*16;
  #pragma unroll
  for(int d0=0;d0<4;++d0){
    const bf16x8 b0=*reinterpret_cast<const bf16x8*>(kb+d0*2048);
    const bf16x8 b1=*reinterpret_cast<const bf16x8*>(kb+d0*2048+512);
    if(d0==0){p0=__builtin_amdgcn_mfma_f32_32x32x16_bf16(b0,qr[0],negm,0,0,0);p1=__builtin_amdgcn_mfma_f32_32x32x16_bf16(b1,qr[0],negm,0,0,0);}
    else{p0=__builtin_amdgcn_mfma_f32_32x32x16_bf16(b0,qr[d0],p0,0,0,0);p1=__builtin_amdgcn_mfma_f32_32x32x16_bf16(b1,qr[d0],p1,0,0,0);}}
}
typedef __attribute__((address_space(3))) const char* lds_cptr;
typedef short v4i16_t __attribute__((ext_vector_type(4)));
__device__ __forceinline__ void kload8(bf16x8*kf,lds_cptr kp){
  kf[0]=*(const __attribute__((address_space(3))) bf16x8*)(kp);      kf[1]=*(const __attribute__((address_space(3))) bf16x8*)(kp+512);
  kf[2]=*(const __attribute__((address_space(3))) bf16x8*)(kp+2048); kf[3]=*(const __attribute__((address_space(3))) bf16x8*)(kp+2560);
  kf[4]=*(const __attribute__((address_space(3))) bf16x8*)(kp+4096); kf[5]=*(const __attribute__((address_space(3))) bf16x8*)(kp+4608);
  kf[6]=*(const __attribute__((address_space(3))) bf16x8*)(kp+6144); kf[7]=*(const __attribute__((address_space(3))) bf16x8*)(kp+6656);
}
__device__ __forceinline__ void kload2(bf16x8*kf,lds_cptr kp,int j){ kf[2*j]=*(const __attribute__((address_space(3))) bf16x8*)(kp+j*2048); kf[2*j+1]=*(const __attribute__((address_space(3))) bf16x8*)(kp+j*2048+512); }
__device__ __forceinline__ s16x4 vtr(lds_cptr p){ return __builtin_bit_cast(s16x4,__builtin_amdgcn_ds_read_tr16_b64_v4i16((__attribute__((address_space(3))) v4i16_t*)p)); }
__device__ __forceinline__ float rowmax(const f32x16&p0,const f32x16&p1){
  float a=max3f(p0[0],p0[1],p1[0]),b=max3f(p0[2],p0[3],p1[1]);a=max3f(a,p1[2],p1[3]);
  #pragma unroll
  for(int r=4;r<16;r+=4){a=max3f(a,p0[r],p0[r+1]);b=max3f(b,p0[r+2],p0[r+3]);a=max3f(a,p1[r],p1[r+1]);b=max3f(b,p1[r+2],p1[r+3]);}
  const float m=max2f(a,b);
  auto rr=__builtin_amdgcn_permlane32_swap(__float_as_uint(m),__float_as_uint(m),false,false);
  return max2f(__uint_as_float(rr[0]),__uint_as_float(rr[1]));
}
__device__ __forceinline__ void pv(f32x16*o,int vb,bf16x8 pa0,bf16x8 pa1,bf16x8 pa2,bf16x8 pa3){
  #pragma unroll
  for(int d0=0;d0<4;++d0){s16x4 lo[4],hi[4];
    #pragma unroll
    for(int ks=0;ks<4;++ks){
      asm volatile("ds_read_b64_tr_b16 %0,%1 offset:%c2":"=&v"(lo[ks]):"v"(vb),"i"(d0*4096+ks*1024):"memory");
      asm volatile("ds_read_b64_tr_b16 %0,%1 offset:%c2":"=&v"(hi[ks]):"v"(vb),"i"(d0*4096+ks*1024+512):"memory");}
    asm volatile("s_waitcnt lgkmcnt(0)":::"memory");SBAR();
    #define PK(k) (bf16x8){lo[k][0],lo[k][1],lo[k][2],lo[k][3],hi[k][0],hi[k][1],hi[k][2],hi[k][3]}
    o[d0]=__builtin_amdgcn_mfma_f32_32x32x16_bf16(pa0,PK(0),o[d0],0,0,0);
    o[d0]=__builtin_amdgcn_mfma_f32_32x32x16_bf16(pa1,PK(1),o[d0],0,0,0);
    o[d0]=__builtin_amdgcn_mfma_f32_32x32x16_bf16(pa2,PK(2),o[d0],0,0,0);
    o[d0]=__builtin_amdgcn_mfma_f32_32x32x16_bf16(pa3,PK(3),o[d0],0,0,0);
    #undef PK
  }
}

#ifndef ATTN_STORE16
#define ATTN_STORE16(p,v) (*(u32x4*)(p)=(v))
#endif
template<int THRL> __device__ __forceinline__ void attn_unit(int b,int qkcol,int vcol,int qb,const bf16*Q,const bf16*__restrict__ K,const bf16*__restrict__ V,bf16*O,char*shm){
  int tid_o=threadIdx.x; asm volatile("":"+v"(tid_o)); const int tid=tid_o,lane=tid&63,r32=lane&31,hi=lane>>5; const int wid=__builtin_amdgcn_readfirstlane(tid>>6);
  const long rowbase=(long)b*SEQ; const int q0=qb*QB;
  const bf16*Qw=Q+(rowbase+q0+wid*QBLK)*DM+qkcol;
  const bf16*Kh=K+rowbase*DM+qkcol,*Vh=V+rowbase*DM+vcol;
  const unsigned lds0=(unsigned)(uintptr_t)shm;
  float*wsf=(float*)(shm+LDS_WS)+wid*64;
  const bf16*ksrc=Kh+(long)lane*DM+wid*8;
  const bf16*vsrc=Vh+(long)(16*(wid&3)+(lane>>2))*DM+(wid>>2)*32+(lane&3)*8;
  const unsigned kdst=lds0+LDS_K+wid*1024, vdst=lds0+LDS_V+wid*1024;
  #define DMA_K(t,slot) glds16(ksrc+(long)(t)*KVBLK*DM,(unsigned)__builtin_amdgcn_readfirstlane(kdst+(slot)))
  #define DMA_V(t,slot) do{ glds16(vsrc+(long)(t)*KVBLK*DM,(unsigned)__builtin_amdgcn_readfirstlane(vdst+2*(slot))); glds16(vsrc+64+(long)(t)*KVBLK*DM,(unsigned)__builtin_amdgcn_readfirstlane(vdst+8192+2*(slot))); }while(0)
  const int vb0=(int)(lds0+LDS_V)+((lane>>4)&1)*32+(lane&3)*8+(4*hi+((lane&15)>>2))*64;
  const char*Kbase=shm+LDS_K; bf16x8 kf[8];
  const lds_cptr shm3=(lds_cptr)shm; const lds_cptr kp0=shm3+LDS_K+hi*1024+r32*16; const lds_cptr vp0=shm3+LDS_V+((lane>>4)&1)*32+(lane&3)*8+(4*hi+((lane&15)>>2))*64;
  const int NT=(q0+QB)/KVBLK;
  DMA_K(0,0);DMA_V(0,0);DMA_K(1,SLOTB);
  bf16x8 qr[4];
  #pragma unroll
  for(int d0=0;d0<4;++d0)qr[d0]=*reinterpret_cast<const bf16x8*>(&Qw[(long)r32*DM+d0*16+hi*8]);
  float mhat=0.f,l_reg=0.f;f32x16 o[4];o[0]=f32x16{};o[1]=f32x16{};o[2]=f32x16{};o[3]=f32x16{};
  const int qrel=wid*QBLK+r32;
  #define CMASK(P0,P1,t) do{int jb_=(t)-(NT-4); if(jb_>=0)cmask(P0,P1,jb_,qrel,hi);}while(0)
  bool resc=false;
  #define START(P0,P1) do{ const float rm=rowmax(P0,P1); resc=false; mhat=rm; \
    _Pragma("unroll") for(int r=0;r<16;++r)P0[r]=__builtin_amdgcn_exp2f(P0[r]-mhat); }while(0)
  #define RESC() do{ if(resc){ asm volatile("s_waitcnt lgkmcnt(0)":::"memory"); \
      _Pragma("unroll") for(int d_=0;d_<4;++d_) _Pragma("unroll") for(int r=0;r<16;++r)o[d_][r]*=wsf[crow(r,hi)]; } }while(0)
  f32x16 pA0,pA1,pB0,pB1; const f32x16 zero16=f32x16{};
  int sl_prev=0,sl_cur=0,sl_next=SLOTB;
  #define ROT() do{sl_prev=sl_cur;sl_cur=sl_next;sl_next=(sl_next==(NSLOT-1)*SLOTB)?0:sl_next+SLOTB;}while(0)
  DMA_K(2,2*SLOTB);
  WAIT_BAR(4);
  qkt(pA0,pA1,Kbase,qr,r32,hi);asm volatile("s_nop 15\n\ts_nop 7":"+v"(pA0),"+v"(pA1));CMASK(pA0,pA1,0);
  START(pA0,pA1);
  _Pragma("unroll") for(int r=0;r<16;++r)pA1[r]=__builtin_amdgcn_exp2f(pA1[r]-mhat);
  WAIT_BAR(0);
  DMA_K(3,0);DMA_V(1,SLOTB);
  ROT();
  kload8(kf,kp0+sl_cur);
  WAIT_BAR(3);
  s16x4 vlo[8],vhi[8]; u32x4 pw0,pw1,pw2,pw3;
  #define PKW(P,B) cvtpk_s(P[B],P[B+1])
  #define PAF(k) __builtin_bit_cast(bf16x8,pw##k)
  #define VFR(i) (bf16x8){vlo[i][0],vlo[i][1],vlo[i][2],vlo[i][3],vhi[i][0],vhi[i][1],vhi[i][2],vhi[i][3]}
  #define PIN(x) asm volatile("":"+v"(x))
  #define MX3(a,b,c) __builtin_fmaxf(__builtin_fmaxf((a),(b)),(c))
  #define GAPA(MF,A0,A1,A2,A3,W0,W1,PW) do{ MF; sacc+=A0; sacc+=A1; sacc+=A2; sacc+=A3; PIN(sacc); W0; W1; PIN(PW); SBAR(); }while(0)
  #define EX(v) __builtin_amdgcn_exp2f(v)
  #define GAPB(MF,X,B) do{ MF; X[B]=EX(X[B]-mhat); X[B+1]=EX(X[B+1]-mhat); PIN(X); SBAR(); }while(0)
  #define VRD2(i) do{ vlo[i]=vtr(vp_+(8192+((i)>>2)*4096+((i)&3)*1024)); vhi[i]=vtr(vp_+(8192+((i)>>2)*4096+((i)&3)*1024+512)); SBAR(); }while(0)
  #define VRD(i) do{ vlo[i]=vtr(vp_+(((i)>>2)*4096+((i)&3)*1024)); vhi[i]=vtr(vp_+(((i)>>2)*4096+((i)&3)*1024+512)); }while(0)
  #define KRD(G,j) do{ if(G){ kload2(kf,kp0+sl_next,j); SBAR(); } }while(0)
  #define STEP(C0,C1,P0,P1,t,GK,GV,GL) do{ SBAR(); \
    const lds_cptr vp_=vp0+2*sl_prev; \
    VRD(0); SBAR(); float sacc=(P0[0]+P0[1]); \
    GAPA(C0=__builtin_amdgcn_mfma_f32_32x32x16_bf16(kf[0],qr[0],zero16,0,0,0), P0[2],P0[3],P0[4],P0[5],     pw0[0]=PKW(P0,0), pw0[1]=PKW(P0,2), pw0); \
    VRD(4); SBAR(); GAPA(C1=__builtin_amdgcn_mfma_f32_32x32x16_bf16(kf[1],qr[0],zero16,0,0,0), P0[6],P0[7],P0[8],P0[9],     pw0[2]=PKW(P0,4), pw0[3]=PKW(P0,6), pw0); \
    VRD(1); SBAR(); GAPA(C0=__builtin_amdgcn_mfma_f32_32x32x16_bf16(kf[2],qr[1],C0,0,0,0),   P0[10],P0[11],P0[12],P0[13], pw1[0]=PKW(P0,8), pw1[1]=PKW(P0,10), pw1); \
    VRD(5); SBAR(); GAPA(C1=__builtin_amdgcn_mfma_f32_32x32x16_bf16(kf[3],qr[1],C1,0,0,0),   P0[14],P0[15],P1[0],P1[1],   pw1[2]=PKW(P0,12),pw1[3]=PKW(P0,14), pw1); \
    VRD(2); SBAR(); GAPA(C0=__builtin_amdgcn_mfma_f32_32x32x16_bf16(kf[4],qr[2],C0,0,0,0),   P1[2],P1[3],P1[4],P1[5],     pw2[0]=PKW(P1,0), pw2[1]=PKW(P1,2), pw2); \
    VRD(6); SBAR(); GAPA(C1=__builtin_amdgcn_mfma_f32_32x32x16_bf16(kf[5],qr[2],C1,0,0,0),   P1[6],P1[7],P1[8],P1[9],     pw2[2]=PKW(P1,4), pw2[3]=PKW(P1,6), pw2); \
    VRD(3); SBAR(); GAPA(C0=__builtin_amdgcn_mfma_f32_32x32x16_bf16(kf[6],qr[3],C0,0,0,0),   P1[10],P1[11],P1[12],P1[13], pw3[0]=PKW(P1,8), pw3[1]=PKW(P1,10), pw3); \
    VRD(7); SBAR(); GAPA(C1=__builtin_amdgcn_mfma_f32_32x32x16_bf16(kf[7],qr[3],C1,0,0,0),   P1[14],P1[15],0.f,0.f,       pw3[2]=PKW(P1,12),pw3[3]=PKW(P1,14), pw3); \
    l_reg+=sacc; \
    if(GK){DMA_K((t)+3,sl_cur);} if(GV){DMA_V((t)+1,sl_next);} \
    CMASK(C0,C1,t); \
    { float a=MX3(C0[0],C0[1],C1[0]),b=MX3(C0[2],C0[3],C1[1]); a=MX3(a,C1[2],C1[3]); \
      _Pragma("unroll") for(int r=4;r<16;r+=4){a=MX3(a,C0[r],C0[r+1]);b=MX3(b,C0[r+2],C0[r+3]);a=MX3(a,C1[r],C1[r+1]);b=MX3(b,C1[r+2],C1[r+3]);} \
      float rm=__builtin_fmaxf(a,b); { auto rr=__builtin_amdgcn_permlane32_swap(__float_as_uint(rm),__float_as_uint(rm),false,false); rm=__builtin_fmaxf(__uint_as_float(rr[0]),__uint_as_float(rr[1])); } \
      resc=false; const float rel=rm-mhat; \
      if(__builtin_expect(__any(rel>(float)THRL),0)){ const float dl=__builtin_fmaxf(rel,0.f); mhat+=dl; \
        const float f=__builtin_amdgcn_exp2f(-dl); l_reg*=f; if(hi==0)wsf[r32]=f; resc=true; } } \
    SBAR(); \
    GAPB(o[0]=__builtin_amdgcn_mfma_f32_32x32x16_bf16(PAF(0),VFR(0),o[0],0,0,0), C0,0); VRD2(0); \
    GAPB(o[1]=__builtin_amdgcn_mfma_f32_32x32x16_bf16(PAF(0),VFR(4),o[1],0,0,0), C0,2); VRD2(4); \
    KRD(GL,0); GAPB(o[0]=__builtin_amdgcn_mfma_f32_32x32x16_bf16(PAF(1),VFR(1),o[0],0,0,0), C0,4); VRD2(1); \
    KRD(GL,1); GAPB(o[1]=__builtin_amdgcn_mfma_f32_32x32x16_bf16(PAF(1),VFR(5),o[1],0,0,0), C0,6); VRD2(5); \
    KRD(GL,2); GAPB(o[0]=__builtin_amdgcn_mfma_f32_32x32x16_bf16(PAF(2),VFR(2),o[0],0,0,0), C0,8); VRD2(2); \
    KRD(GL,3); GAPB(o[1]=__builtin_amdgcn_mfma_f32_32x32x16_bf16(PAF(2),VFR(6),o[1],0,0,0), C0,10); VRD2(6); \
    GAPB(o[0]=__builtin_amdgcn_mfma_f32_32x32x16_bf16(PAF(3),VFR(3),o[0],0,0,0), C0,12); VRD2(3); \
    GAPB(o[1]=__builtin_amdgcn_mfma_f32_32x32x16_bf16(PAF(3),VFR(7),o[1],0,0,0), C0,14); VRD2(7); \
    GAPB(o[2]=__builtin_amdgcn_mfma_f32_32x32x16_bf16(PAF(0),VFR(0),o[2],0,0,0), C1,0); \
    GAPB(o[3]=__builtin_amdgcn_mfma_f32_32x32x16_bf16(PAF(0),VFR(4),o[3],0,0,0), C1,2); \
    GAPB(o[2]=__builtin_amdgcn_mfma_f32_32x32x16_bf16(PAF(1),VFR(1),o[2],0,0,0), C1,4); \
    GAPB(o[3]=__builtin_amdgcn_mfma_f32_32x32x16_bf16(PAF(1),VFR(5),o[3],0,0,0), C1,6); \
    GAPB(o[2]=__builtin_amdgcn_mfma_f32_32x32x16_bf16(PAF(2),VFR(2),o[2],0,0,0), C1,8); \
    GAPB(o[3]=__builtin_amdgcn_mfma_f32_32x32x16_bf16(PAF(2),VFR(6),o[3],0,0,0), C1,10); \
    GAPB(o[2]=__builtin_amdgcn_mfma_f32_32x32x16_bf16(PAF(3),VFR(3),o[2],0,0,0), C1,12); \
    GAPB(o[3]=__builtin_amdgcn_mfma_f32_32x32x16_bf16(PAF(3),VFR(7),o[3],0,0,0), C1,14); \
    }while(0)
  int t=1;
  #undef CMASK
  #define CMASK(P0,P1,t) do{}while(0)
  for(;t+5<NT;t+=2){
    STEP(pB0,pB1,pA0,pA1,t,true,true,true);     WAIT_BAR(3); RESC(); ROT();
    STEP(pA0,pA1,pB0,pB1,t+1,true,true,true);   WAIT_BAR(3); RESC(); ROT();
  }
  #undef CMASK
  #define CMASK(P0,P1,t) do{int jb_=(t)-(NT-4); if(jb_>=0)cmask(P0,P1,jb_,qrel,hi);}while(0)
  #define ENDW(tt) do{ if((tt)+3<NT){WAIT_BAR(3);} else if((tt)+2<NT){WAIT_BAR(2);} else {WAIT_BAR(0);} }while(0)
  for(;t+1<NT;t+=2){
    STEP(pB0,pB1,pA0,pA1,t,(t+3<NT),(t+1<NT),(t+1<NT));       ENDW(t);   RESC(); ROT();
    STEP(pA0,pA1,pB0,pB1,t+1,(t+4<NT),(t+2<NT),(t+2<NT));     ENDW(t+1); RESC(); ROT();
  }
  STEP(pB0,pB1,pA0,pA1,NT-1,false,false,false); RESC();
  { float sacc=pB0[0]+pB0[1]; _Pragma("unroll") for(int r=2;r<16;++r)sacc+=pB0[r]; _Pragma("unroll") for(int r=0;r<16;++r)sacc+=pB1[r]; l_reg+=sacc;
    pw0=(u32x4){PKW(pB0,0),PKW(pB0,2),PKW(pB0,4),PKW(pB0,6)};pw1=(u32x4){PKW(pB0,8),PKW(pB0,10),PKW(pB0,12),PKW(pB0,14)};pw2=(u32x4){PKW(pB1,0),PKW(pB1,2),PKW(pB1,4),PKW(pB1,6)};pw3=(u32x4){PKW(pB1,8),PKW(pB1,10),PKW(pB1,12),PKW(pB1,14)};
    SBAR(); pv(o,vb0+2*sl_cur,PAF(0),PAF(1),PAF(2),PAF(3)); }
  #undef PKW
  #undef PAF
  #undef VFR
  #undef PIN
  #undef MX3
  #undef GAPA
  #undef GAPB
  #undef VRD2
  #undef EX
  #undef VRD
  #undef KRD
  #undef STEP
  #undef ENDW
  {auto rr=__builtin_amdgcn_permlane32_swap(__float_as_uint(l_reg),__float_as_uint(l_reg),false,false);l_reg=__uint_as_float(rr[0])+__uint_as_float(rr[1]);}
  if(hi==0)wsf[32+r32]=l_reg;asm volatile("s_waitcnt lgkmcnt(0)":::"memory");
  float rli[16];
  #pragma unroll
  for(int r=0;r<16;++r)rli[r]=__builtin_amdgcn_rcpf(wsf[32+crow(r,hi)]);
  bf16*Ow=O+(rowbase+q0+wid*QBLK)*DM+vcol;
  { bf16*stg=(bf16*)(shm+LDS_OST)+wid*4096;
    #pragma unroll
    for(int r=0;r<16;++r){const int orow=crow(r,hi);
      #pragma unroll
      for(int d0=0;d0<4;++d0)stg[orow*128+d0*32+r32]=__float2bfloat16(o[d0][r]*rli[r]);}
    asm volatile("s_waitcnt lgkmcnt(0)":::"memory");
    #pragma unroll
    for(int i=0;i<8;++i){const int row=i*4+(lane>>4),ch=lane&15; const u32x4 v=*(const u32x4*)(stg+row*128+ch*8); ATTN_STORE16(Ow+(long)row*DM+ch*8,v);} }
  asm volatile("s_waitcnt lgkmcnt(0)\n\ts_barrier":::"memory");
  #undef DMA_K
  #undef DMA_V
  #undef CMASK
  #undef START
  #undef RESC
  #undef ROT
}
constexpr int ATTN_LDS_BYTES=LDS_BYTES;
struct AttnTensors { const bf16* Q; const bf16* K; const bf16* V; bf16* O0; bf16* O1; };
struct AttnUnit { int bh; int qb; };
struct StaticOrder {
  int vcu;
  __device__ __forceinline__ explicit StaticOrder(int grid,int block):vcu((block%8)*(grid/8)+block/8){}
  __device__ __forceinline__ bool next(int i,AttnUnit&u)const{ if(i>=4)return false; const int s=vcu&7; u.bh=vcu>>3; u.qb=(i==0)?s:(i==1)?15-s:(i==2)?16+s:31-s; return true; }
};
template<class Sched,int THRL=8> __device__ __forceinline__ void attn_phase(char*lds,const AttnTensors&T,const Sched&S){
  AttnUnit u;
  for(int i=0;S.next(i,u);++i){ const int b=u.bh/NHEAD,hh=u.bh%NHEAD; attn_unit<THRL>(b,hh*64,(hh>>1)*128,u.qb,T.Q,T.K,T.V,(hh&1)?T.O1:T.O0,lds); }
}
#undef SBAR
#undef WAIT_BAR
}
#define GAS __attribute__((address_space(1)))
#define LAS __attribute__((address_space(3)))
typedef unsigned short bf16;
typedef unsigned v4u __attribute__((ext_vector_type(4)));
typedef float f32x4 __attribute__((ext_vector_type(4)));
typedef short bf16x8 __attribute__((ext_vector_type(8)));
typedef GAS unsigned gu32;
typedef GAS unsigned long long gu64;
#define RLX_AGENT __ATOMIC_RELAXED, __HIP_MEMORY_SCOPE_AGENT
#define LDS_WAIT() asm volatile("s_waitcnt lgkmcnt(0)" ::: "memory")
#define VM_WAIT() asm volatile("s_waitcnt vmcnt(0)" ::: "memory")
__device__ __forceinline__ unsigned long long rt() { return __builtin_amdgcn_s_memrealtime(); }
__device__ __forceinline__ unsigned f2bf(float f) { unsigned u = __builtin_bit_cast(unsigned, f); return (u + 0x7fffu + ((u >> 16) & 1u)) >> 16; }
__device__ __forceinline__ unsigned pk2(float lo, float hi) { return f2bf(lo) | (f2bf(hi) << 16); }

#define XB_TMO      128
#define XB_XCNT(j)  (256  + 64 * (j))
#define XB_XSUB(j)  (1280 + 64 * (j))
#define XB_XGEN(j)  (2304 + 64 * (j))
#define XB_TOP      3328
#define XB_TOPGEN   3392
#define XCD_BAR_WORDS 3456
#define XB_SPIN_CAP (1u << 18)

__device__ __forceinline__ unsigned xb_ld(unsigned* p)              { return __hip_atomic_load(p, __ATOMIC_RELAXED, __HIP_MEMORY_SCOPE_AGENT); }
__device__ __forceinline__ unsigned xb_add(unsigned* p, unsigned v) { return __hip_atomic_fetch_add(p, v, __ATOMIC_RELAXED, __HIP_MEMORY_SCOPE_AGENT); }
__device__ __forceinline__ unsigned xb_xcc_id() { return (unsigned)__builtin_amdgcn_s_getreg((3 << 11) | 20) & 0xFu; }
#define XB_SPIN(cond, bar) do { unsigned _sp = 0; while (cond) { __builtin_amdgcn_s_sleep(1); \
    if ((++_sp & 255u) == 0u) { if (xb_ld(&(bar)[XB_TMO])) break; if (_sp > XB_SPIN_CAP) { atomicAdd(&(bar)[XB_TMO], 1u); break; } } } } while (0)

struct XcdBarrier {
    unsigned* bar; unsigned x;
    volatile LAS unsigned* st;
};

__device__ __forceinline__ XcdBarrier xcd_barrier_post(unsigned* bar, volatile LAS unsigned* st) {
    XcdBarrier b; b.bar = bar; b.x = xb_xcc_id(); b.st = st;
    if (threadIdx.x == 0) (void)xb_add(&bar[XB_XCNT(b.x)], 1u);
    return b;
}
__device__ __forceinline__ void xcd_barrier_complete(unsigned* bar, unsigned x, unsigned& nloc, unsigned& nx) {
    const unsigned G = gridDim.x * gridDim.y * gridDim.z;
    unsigned sum, cnt, mine, sp = 0u;
    for (;;) {
        sum = 0u; cnt = 0u; mine = 0u;
#pragma unroll
        for (unsigned j = 0; j < 16; ++j) { const unsigned c = xb_ld(&bar[XB_XCNT(j)]); sum += c; cnt += (c > 0u) ? 1u : 0u; mine = (j == x) ? c : mine; }
        if (sum == G) break;
        __builtin_amdgcn_s_sleep(1);
        if ((++sp & 255u) == 0u) { if (xb_ld(&bar[XB_TMO])) break; if (sp > XB_SPIN_CAP) { atomicAdd(&bar[XB_TMO], 1u); break; } }
    }
    nloc = mine > 0u ? mine : 1u; nx = cnt > 0u ? cnt : 1u;
}

__device__ __forceinline__ void xcd_barrier(const XcdBarrier& b) {
    asm volatile("s_waitcnt vmcnt(0)" ::: "memory");
    __syncthreads();
    if (threadIdx.x == 0) {
        unsigned* bar = b.bar;
        __builtin_amdgcn_s_waitcnt(0);
        unsigned nloc = b.st[0], nx = b.st[1];
        if (nloc == 0u) { xcd_barrier_complete(bar, b.x, nloc, nx); b.st[0] = nloc; b.st[1] = nx; }
        const unsigned old = xb_add(&bar[XB_XSUB(b.x)], 1u);
        const unsigned gen = old / nloc;
        if (old + 1u == (gen + 1u) * nloc) {
            __builtin_amdgcn_fence(__ATOMIC_RELEASE, "agent");
            asm volatile("s_waitcnt vmcnt(0)" ::: "memory");
            const unsigned og = xb_add(&bar[XB_TOP], 1u);
            const unsigned tg = og / nx;
            if (og + 1u == (tg + 1u) * nx) xb_add(&bar[XB_TOPGEN], 1u);
            else XB_SPIN(xb_ld(&bar[XB_TOPGEN]) == tg, bar);
            __builtin_amdgcn_fence(__ATOMIC_ACQUIRE, "agent");
            xb_add(&bar[XB_XGEN(b.x)], 1u);
            asm volatile("s_waitcnt vmcnt(0)" ::: "memory");
        } else {
            XB_SPIN(xb_ld(&bar[XB_XGEN(b.x)]) == gen, bar);
            __builtin_amdgcn_fence(__ATOMIC_ACQUIRE, "agent");
            asm volatile("s_waitcnt vmcnt(0)" ::: "memory");
        }
    }
    __syncthreads();
}
namespace ret {
#define RLAS __attribute__((address_space(3)))
typedef unsigned short bf16_t;
typedef float f32x16 __attribute__((ext_vector_type(16)));
typedef float f32x4 __attribute__((ext_vector_type(4)));
typedef float f32x2 __attribute__((ext_vector_type(2)));
typedef short bf16x8 __attribute__((ext_vector_type(8)));
typedef short s16x4 __attribute__((ext_vector_type(4)));
typedef unsigned u32x4 __attribute__((ext_vector_type(4)));
typedef unsigned u32x2 __attribute__((ext_vector_type(2)));
typedef __bf16 bf16x2_t __attribute__((ext_vector_type(2)));
constexpr int QS = 272, KRS = 272, KTS = 320, VTS = 576;
constexpr int L_Q = 0, L_KR = 64 * QS, L_KT = L_KR + 64 * KRS, L_V = L_KT + 64 * KTS, L_ST = L_V + 64 * VTS, L_END = L_ST + 8 * 64 * 8;
constexpr float GN_EPS = 1e-6f;
__device__ __forceinline__ unsigned pkbf(float lo, float hi) { f32x2 v = {lo, hi}; bf16x2_t b = __builtin_convertvector(v, bf16x2_t); return __builtin_bit_cast(unsigned, b); }
template <int S> __device__ __forceinline__ bf16x8 cvt8(const f32x16& x) {
    u32x4 w; w.x = pkbf(x[8 * S + 0], x[8 * S + 1]); w.y = pkbf(x[8 * S + 2], x[8 * S + 3]); w.z = pkbf(x[8 * S + 4], x[8 * S + 5]); w.w = pkbf(x[8 * S + 6], x[8 * S + 7]);
    return __builtin_bit_cast(bf16x8, w);
}
__device__ __forceinline__ bf16x8 trfrag(RLAS const unsigned char* p, int step8) {
    typedef short v4i16_t __attribute__((ext_vector_type(4)));
    const s16x4 lo = __builtin_bit_cast(s16x4, __builtin_amdgcn_ds_read_tr16_b64_v4i16((RLAS v4i16_t*)p));
    const s16x4 hi = __builtin_bit_cast(s16x4, __builtin_amdgcn_ds_read_tr16_b64_v4i16((RLAS v4i16_t*)(p + step8)));
    return (bf16x8){lo[0], lo[1], lo[2], lo[3], hi[0], hi[1], hi[2], hi[3]};
}
#define RMFMA(a, b, c) __builtin_amdgcn_mfma_f32_32x32x16_bf16(a, b, c, 0, 0, 0)

struct Bufs { const bf16_t* Q; const bf16_t* KD; bf16_t* V; float* L; const float* lgtab; };

template <bool FULL> __device__ __forceinline__ void stage(RLAS unsigned char* lds, const Bufs& B, size_t row0, int h, int tid) {
    u32x4 kq[2], kk[2], vv[4];
#pragma unroll
    for (int i = 0; i < 2; ++i) { const int piece = tid + 512 * i, row = piece >> 4, ch = piece & 15; const size_t off = (row0 + row) * 1024 + h * 128 + ch * 8;
        kk[i] = *(const u32x4*)(B.KD + off); if (FULL) kq[i] = *(const u32x4*)(B.Q + off); }
#pragma unroll
    for (int i = 0; i < 4; ++i) { const int piece = tid + 512 * i, row = piece >> 5, ch = piece & 31; vv[i] = *(const u32x4*)(B.V + (row0 + row) * 2048 + h * 256 + ch * 8); }
#pragma unroll
    for (int i = 0; i < 2; ++i) { const int piece = tid + 512 * i, row = piece >> 4, ch = piece & 15;
        *(RLAS u32x4*)(lds + L_KT + row * KTS + ch * 16) = kk[i];
        if (FULL) { *(RLAS u32x4*)(lds + L_KR + row * KRS + ch * 16) = kk[i]; *(RLAS u32x4*)(lds + L_Q + row * QS + ch * 16) = kq[i]; } }
#pragma unroll
    for (int i = 0; i < 4; ++i) { const int piece = tid + 512 * i, row = piece >> 5, ch = piece & 31; *(RLAS u32x4*)(lds + L_V + row * VTS + ch * 16) = vv[i]; }
}

__device__ __forceinline__ void state_update(f32x16 (&st)[4], const bf16x8 (&vf)[4], RLAS const unsigned char* kbase, float cd) {
#pragma unroll
    for (int dt = 0; dt < 4; ++dt) st[dt] = st[dt] * cd;
#pragma unroll
    for (int ks = 0; ks < 4; ++ks)
#pragma unroll
        for (int dt = 0; dt < 4; ++dt) { const bf16x8 a = trfrag(kbase + ks * 16 * KTS + dt * 64, 8 * KTS); st[dt] = RMFMA(a, vf[ks], st[dt]); }
    __builtin_amdgcn_sched_barrier(0);
}

__device__ __forceinline__ void r1_unit(RLAS unsigned char* lds, const Bufs& B, int unit) {
    int tid_o = threadIdx.x; asm volatile("" : "+v"(tid_o));
    const int tid = tid_o, lane = tid & 63, w = __builtin_amdgcn_readfirstlane(tid >> 6), hh = lane >> 5, g1 = (lane >> 4) & 1, q = (lane & 15) >> 2, p = lane & 3;
    const int g = unit & 15, h = (unit >> 4) & 7, b = unit >> 7;
    const float lg = B.lgtab[h], cd = __builtin_amdgcn_exp2f(64.f * lg);
    RLAS const unsigned char* vbase = lds + L_V + (4 * hh + q) * VTS + (32 * w + 16 * g1 + 4 * p) * 2;
    RLAS const unsigned char* kbase = lds + L_KT + (4 * hh + q) * KTS + (16 * g1 + 4 * p) * 2;
    f32x16 st[4];
#pragma unroll
    for (int dt = 0; dt < 4; ++dt)
#pragma unroll
        for (int e = 0; e < 16; ++e) st[dt][e] = 0.f;
    const size_t row0 = (size_t)b * 8192 + (size_t)g * 512;
    for (int j = 0; j < 8; ++j) {
        __syncthreads();
        stage<false>(lds, B, row0 + 64 * j, h, tid);
        __syncthreads();
        bf16x8 vf[4];
#pragma unroll
        for (int ks = 0; ks < 4; ++ks) vf[ks] = trfrag(vbase + ks * 16 * VTS, 8 * VTS);
        state_update(st, vf, kbase, cd);
    }
    float* Lp = B.L + ((size_t)unit * 8 + w) * 4096 + lane * 4;
#pragma unroll
    for (int dt = 0; dt < 4; ++dt)
#pragma unroll
        for (int k4 = 0; k4 < 4; ++k4) *(f32x4*)(Lp + (dt * 4 + k4) * 256) = (f32x4){st[dt][4 * k4], st[dt][4 * k4 + 1], st[dt][4 * k4 + 2], st[dt][4 * k4 + 3]};
}

__device__ __forceinline__ void r3_unit(RLAS unsigned char* lds, const Bufs& B, int unit) {
    int tid_o = threadIdx.x; asm volatile("" : "+v"(tid_o));
    const int tid = tid_o, lane = tid & 63, w = __builtin_amdgcn_readfirstlane(tid >> 6), r = lane & 31, hh = lane >> 5, g1 = (lane >> 4) & 1, q = (lane & 15) >> 2, p = lane & 3;
    const int g = unit & 15, h = (unit >> 4) & 7, b = unit >> 7;
    const float lg = B.lgtab[h], cd = __builtin_amdgcn_exp2f(64.f * lg), cd8 = __builtin_amdgcn_exp2f(512.f * lg);
    float qdec[2], smask[2];
#pragma unroll
    for (int ct = 0; ct < 2; ++ct) { const float c = (float)(32 * ct + r); qdec[ct] = __builtin_amdgcn_exp2f((c + 1.f) * lg); smask[ct] = __builtin_amdgcn_exp2f((c - 63.f) * lg); }
    RLAS const unsigned char* vbase = lds + L_V + (4 * hh + q) * VTS + (32 * w + 16 * g1 + 4 * p) * 2;
    RLAS const unsigned char* kbase = lds + L_KT + (4 * hh + q) * KTS + (16 * g1 + 4 * p) * 2;
    RLAS const unsigned char* qrow = lds + L_Q + r * QS + hh * 16;
    RLAS const unsigned char* krow = lds + L_KR + r * KRS + hh * 16;
    RLAS const unsigned char* qprm = lds + L_Q + r * QS + hh * 8;
    RLAS f32x2* ST = (RLAS f32x2*)(lds + L_ST);
    f32x16 st[4];
#pragma unroll
    for (int dt = 0; dt < 4; ++dt)
#pragma unroll
        for (int e = 0; e < 16; ++e) st[dt][e] = 0.f;
    for (int gp = 0; gp < g; ++gp) {
        const float* Lp = B.L + ((size_t)(unit - g + gp) * 8 + w) * 4096 + lane * 4;
#pragma unroll
        for (int dt = 0; dt < 4; ++dt)
#pragma unroll
            for (int k4 = 0; k4 < 4; ++k4) { const f32x4 v = *(const f32x4*)(Lp + (dt * 4 + k4) * 256);
#pragma unroll
                for (int e = 0; e < 4; ++e) st[dt][4 * k4 + e] = st[dt][4 * k4 + e] * cd8 + v[e]; }
    }
    const size_t row0 = (size_t)b * 8192 + (size_t)g * 512;
    for (int j = 0; j < 8; ++j) {
        __syncthreads();
        stage<true>(lds, B, row0 + 64 * j, h, tid);
        __syncthreads();
        bf16x8 vf[4];
#pragma unroll
        for (int ks = 0; ks < 4; ++ks) vf[ks] = trfrag(vbase + ks * 16 * VTS, 8 * VTS);
        f32x16 oT[2];
#pragma unroll
        for (int ct = 0; ct < 2; ++ct)
#pragma unroll
            for (int e = 0; e < 16; ++e) oT[ct][e] = 0.f;
#pragma unroll
        for (int dt = 0; dt < 4; ++dt) {
            const bf16x8 a0 = cvt8<0>(st[dt]), a1 = cvt8<1>(st[dt]);
#pragma unroll
            for (int ct = 0; ct < 2; ++ct) {
                RLAS const unsigned char* qp = qprm + ct * 32 * QS + dt * 64;
                const u32x2 l0 = *(RLAS const u32x2*)(qp), h0 = *(RLAS const u32x2*)(qp + 16), l1 = *(RLAS const u32x2*)(qp + 32), h1 = *(RLAS const u32x2*)(qp + 48);
                const bf16x8 b0 = __builtin_bit_cast(bf16x8, (u32x4){l0.x, l0.y, h0.x, h0.y}), b1 = __builtin_bit_cast(bf16x8, (u32x4){l1.x, l1.y, h1.x, h1.y});
                oT[ct] = RMFMA(a0, b0, oT[ct]); oT[ct] = RMFMA(a1, b1, oT[ct]);
            }
            __builtin_amdgcn_sched_barrier(0);
        }
#pragma unroll
        for (int ct = 0; ct < 2; ++ct) oT[ct] = oT[ct] * qdec[ct];
#pragma unroll
        for (int ct = 0; ct < 2; ++ct)
#pragma unroll
            for (int ctp = 0; ctp <= ct; ++ctp) {
                f32x16 sT;
#pragma unroll
                for (int e = 0; e < 16; ++e) sT[e] = 0.f;
#pragma unroll
                for (int ks = 0; ks < 8; ++ks) { const bf16x8 a = *(RLAS const bf16x8*)(krow + ctp * 32 * KRS + ks * 32), bq = *(RLAS const bf16x8*)(qrow + ct * 32 * QS + ks * 32); sT = RMFMA(a, bq, sT); }
#pragma unroll
                for (int e = 0; e < 16; ++e) { const int cp = (e & 3) + 8 * (e >> 2) + 4 * hh; const bool keep = (ctp < ct) || (cp <= r); sT[e] = keep ? sT[e] * smask[ct] : 0.f; }
                oT[ct] = RMFMA(vf[2 * ctp], cvt8<0>(sT), oT[ct]); oT[ct] = RMFMA(vf[2 * ctp + 1], cvt8<1>(sT), oT[ct]);
                __builtin_amdgcn_sched_barrier(0);
            }
#pragma unroll
        for (int ct = 0; ct < 2; ++ct) { float s1 = 0.f, s2 = 0.f;
#pragma unroll
            for (int e = 0; e < 16; ++e) { s1 += oT[ct][e]; s2 += oT[ct][e] * oT[ct][e]; }
            s1 += __shfl_xor(s1, 32); s2 += __shfl_xor(s2, 32);
            if (hh == 0) ST[w * 64 + 32 * ct + r] = (f32x2){s1, s2}; }
        __syncthreads();
#pragma unroll
        for (int ct = 0; ct < 2; ++ct) { float s1 = 0.f, s2 = 0.f;
#pragma unroll
            for (int ww = 0; ww < 8; ++ww) { const f32x2 t = ST[ww * 64 + 32 * ct + r]; s1 += t.x; s2 += t.y; }
            const float mean = s1 * (1.f / 256.f), var = fmaxf(s2 * (1.f / 256.f) - mean * mean, 0.f), rstd = 1.0f / sqrtf(var + GN_EPS);
            bf16_t* op = B.V + (row0 + 64 * j + 32 * ct + r) * 2048 + h * 256 + 32 * w + 4 * hh;
#pragma unroll
            for (int k4 = 0; k4 < 4; ++k4) { u32x2 o; o.x = pkbf((oT[ct][4 * k4] - mean) * rstd, (oT[ct][4 * k4 + 1] - mean) * rstd); o.y = pkbf((oT[ct][4 * k4 + 2] - mean) * rstd, (oT[ct][4 * k4 + 3] - mean) * rstd);
                *(u32x2*)(op + 8 * k4) = o; } }
        state_update(st, vf, kbase, cd);
    }
}
#undef RMFMA
#undef RLAS
}
constexpr int NWAVES = 8;
constexpr int BATCH = 2, SEQ = 8192, DM = 1024, M = BATCH * SEQ;
constexpr float EPS = 1e-6f;
constexpr float C2 = 0.125f * 1.4426950408889634f;
constexpr float LAMBDA_INIT2 = 0.4707130183384360f;
constexpr float LAMBDA_INIT3 = 0.5560582041564060f;

constexpr size_t MiB = 1u << 20;
constexpr size_t WS_CTL = 0, CTL_ZERO_BYTES = 64 * 1024;
constexpr size_t WS_MISC = 512 * 1024;
constexpr size_t WS_CS128 = 1 * MiB;
constexpr size_t WS_CS64 = 5 * MiB;
constexpr size_t WS_WINA = 8 * MiB;
constexpr size_t WS_WOUTA = 32 * MiB;
constexpr size_t WS_WKVQ = 40 * MiB;
constexpr size_t WS_W3 = 48 * MiB;
constexpr size_t WS_WOUTB = 52 * MiB;
constexpr size_t WS_XN = 56 * MiB;
constexpr size_t WS_R = 88 * MiB;
constexpr size_t WS_L = 216 * MiB;
constexpr size_t WS_END = 248 * MiB;
constexpr int CW_BAR = 1024;

constexpr int RING_OFF = 0, RING_BYTES = 143360;
constexpr int LDSCTL_OFF = RING_BYTES, MISC_OFF = LDSCTL_OFF + 320;
constexpr int LDS_BYTES = 147456;
static_assert(attn_body::ATTN_LDS_BYTES <= RING_BYTES && ret::L_END <= RING_BYTES && pg8::STAGE_BYTES <= RING_BYTES && MISC_OFF + 128 <= LDS_BYTES, "LDS map");

struct Args {
    const float* x; const float* pre_norm; const float* post_norm; const float* w_in_a; const float* w_out_a; const float* kv_norm; const float* w_kv; const float* w_in_b;
    const float* lam_q1; const float* lam_k1; const float* lam_q2; const float* lam_k2; const float* sub_norm_b; const float* w_out_b;
    float* out; unsigned char* ws; int ph_lo, ph_hi, use_bar, pad;
};

__device__ __forceinline__ float wave_sum(float v) {
#pragma unroll
    for (int o = 1; o < 64; o <<= 1) v += __shfl_xor(v, o);
    return v;
}
__device__ __forceinline__ unsigned pkbf(float lo, float hi) { return pg8::pkbf(lo, hi); }

template <int PERM> __device__ __forceinline__ void transpose_item(const float* W, int ldw, int c0, int ncols, int K, const float* gain, bf16* WT, int row_off, int plim, LAS float* scr, int item, int lane) {
    const int nblk = ncols / 32, kb = item / nblk, nb = item % nblk, k0 = 64 * kb, n0 = 32 * nb;
#pragma unroll 8
    for (int i = 0; i < 32; ++i) { const int kk = 2 * i + (lane >> 5); float v = W[(size_t)(k0 + kk) * ldw + c0 + n0 + (lane & 31)]; if (gain) v *= gain[k0 + kk]; scr[kk * 33 + (lane & 31)] = v; }
    LDS_WAIT(); asm volatile("" ::: "memory");
    const int c = lane & 7;
#pragma unroll
    for (int j = 0; j < 4; ++j) { const int n = (lane >> 3) + 8 * j, nn = n0 + n; const LAS float* s = scr + (8 * c) * 33 + n;
        int dr = nn;
        if (PERM == 1 && nn < plim) dr = (nn & ~127) | (2 * (nn & 63) + ((nn >> 6) & 1));
        if (PERM == 2 && nn < plim) dr = (nn & ~63) | (2 * (nn & 31) + ((nn >> 5) & 1));
        v4u o; o.x = pkbf(s[0 * 33], s[1 * 33]); o.y = pkbf(s[2 * 33], s[3 * 33]); o.z = pkbf(s[4 * 33], s[5 * 33]); o.w = pkbf(s[6 * 33], s[7 * 33]);
        *(GAS v4u*)(WT + (size_t)(row_off + dr) * K + k0 + 8 * c) = o; }
    LDS_WAIT(); asm volatile("" ::: "memory");
}
__device__ __forceinline__ void row_to_xn(const float* xrow, bf16* orow, int lane) {
    const GAS f32x4* xr = (const GAS f32x4*)xrow + lane;
    f32x4 v[4]; float s = 0.f;
#pragma unroll
    for (int j = 0; j < 4; ++j) { v[j] = xr[64 * j]; s += (v[j].x * v[j].x + v[j].y * v[j].y) + (v[j].z * v[j].z + v[j].w * v[j].w); }
    const float rstd = 1.f / sqrtf(wave_sum(s) * (1.f / DM) + EPS);
    GAS unsigned long long* o8 = (GAS unsigned long long*)orow + lane;
#pragma unroll
    for (int j = 0; j < 4; ++j) o8[64 * j] = (unsigned long long)pkbf(v[j].x * rstd, v[j].y * rstd) | ((unsigned long long)pkbf(v[j].z * rstd, v[j].w * rstd) << 32);
}
__device__ __forceinline__ void sincos_rev(float ang, float& c, float& s) {
    const double t = (double)ang * 0.15915494309189535; const float f = (float)(t - __builtin_rint(t));
    s = __builtin_amdgcn_sinf(f); c = __builtin_amdgcn_cosf(f);
}

__device__ __forceinline__ void p0_prologue(const Args& A, LAS unsigned char* lds, int vcu, int G, int wave, int lane, int tid) {
    unsigned char* ws = A.ws;
    LAS float* scr = (LAS float*)(lds + RING_OFF + wave * 16384);
    const int gw = vcu * NWAVES + wave, NGW = G * NWAVES;
    bf16* WinA = (bf16*)(ws + WS_WINA); bf16* WoutA = (bf16*)(ws + WS_WOUTA); bf16* Wkvq = (bf16*)(ws + WS_WKVQ); bf16* W3 = (bf16*)(ws + WS_W3); bf16* WoutB = (bf16*)(ws + WS_WOUTB);
    constexpr int I_INA = 16 * 192, I_OUTA = 32 * 32, I_KV = 16 * 64, I_INB = 16 * 64, I_OUTB = 16 * 32;
    constexpr int NITEMS = 2 * I_INA + 2 * I_OUTA + I_KV + 2 * I_INB + 2 * I_OUTB;
    for (int it = gw; it < NITEMS; it += NGW) {
        int r = it;
        if (r < 2 * I_INA) { const int l = r / I_INA; r -= l * I_INA;
            transpose_item<1>(A.w_in_a + (size_t)l * 1024 * 6144, 6144, 0, 6144, 1024, A.pre_norm + l * 1024, WinA + (size_t)l * 6144 * 1024, 0, 2048, scr, r, lane); continue; }
        r -= 2 * I_INA;
        if (r < 2 * I_OUTA) { const int l = r / I_OUTA; r -= l * I_OUTA;
            transpose_item<0>(A.w_out_a + (size_t)l * 2048 * 1024, 1024, 0, 1024, 2048, nullptr, WoutA + (size_t)l * 1024 * 2048, 0, 0, scr, r, lane); continue; }
        r -= 2 * I_OUTA;
        if (r < I_KV) { transpose_item<2>(A.w_kv, 2048, 0, 2048, 1024, A.kv_norm, Wkvq, 0, 1024, scr, r, lane); continue; }
        r -= I_KV;
        if (r < I_INB) { transpose_item<2>(A.w_in_b, 2048, 0, 2048, 1024, A.pre_norm + 2 * 1024, Wkvq, 2048, 1024, scr, r, lane); continue; }
        r -= I_INB;
        if (r < I_INB) { transpose_item<2>(A.w_in_b + (size_t)1024 * 2048, 2048, 0, 2048, 1024, A.pre_norm + 3 * 1024, W3, 0, 1024, scr, r, lane); continue; }
        r -= I_INB;
        { const int l = r / I_OUTB; r -= l * I_OUTB;
          transpose_item<0>(A.w_out_b + (size_t)l * 1024 * 1024, 1024, 0, 1024, 1024, nullptr, WoutB + (size_t)l * 1024 * 1024, 0, 0, scr, r, lane); }
    }
    { float* cs128 = (float*)(ws + WS_CS128); float* cs64 = (float*)(ws + WS_CS64); const int gt = vcu * (NWAVES * 64) + tid, NGT = G * NWAVES * 64;
      for (int e = gt; e < 8192 * 64; e += NGT) { const int pos = e >> 6, i = e & 63; const float inv = powf(10000.0f, -(float)i / 64.0f); float c, s; sincos_rev((float)pos * inv, c, s); *(float2*)(cs128 + 2 * (size_t)e) = make_float2(c, s); }
      for (int e = gt; e < 8192 * 32; e += NGT) { const int pos = e >> 5, i = e & 31; const float inv = powf(10000.0f, -(float)i / 32.0f); float c, s; sincos_rev((float)pos * inv, c, s); *(float2*)(cs64 + 2 * (size_t)e) = make_float2(c, s); }
      if (gt < 8) { float* misc = (float*)(ws + WS_MISC); misc[gt] = log1pf(-exp2f(-5.0f - (float)gt)) * 1.4426950408889634f; }
      if (vcu == 0 && wave == 1) {
          float* misc = (float*)(ws + WS_MISC);
          for (int j = 0; j < 2; ++j) { const float a = wave_sum(A.lam_q1[j * 64 + lane] * A.lam_k1[j * 64 + lane]), b2 = wave_sum(A.lam_q2[j * 64 + lane] * A.lam_k2[j * 64 + lane]);
              if (lane == 0) misc[16 + j] = expf(a) - expf(b2) + (j == 0 ? LAMBDA_INIT2 : LAMBDA_INIT3); } } }
    for (int m = gw; m < M; m += NGW) row_to_xn(A.x + (size_t)m * DM, (bf16*)(ws + WS_XN) + (size_t)m * DM, lane);
}

__device__ __forceinline__ void norm_phase(const float* Y, const float* base, const float* gpost, float* out, bf16* XN, bool write_xn, int gw, int NGW, int lane) {
    f32x4 gp[4];
#pragma unroll
    for (int j = 0; j < 4; ++j) gp[j] = ((const f32x4*)gpost)[lane + 64 * j];
    for (int m = gw; m < M; m += NGW) {
        const GAS f32x4* yr = (const GAS f32x4*)(Y + (size_t)m * DM) + lane; const GAS f32x4* br = (const GAS f32x4*)(base + (size_t)m * DM) + lane;
        f32x4 y[4], xb[4]; float s = 0.f;
#pragma unroll
        for (int j = 0; j < 4; ++j) { y[j] = yr[64 * j]; xb[j] = br[64 * j]; s += (y[j].x * y[j].x + y[j].y * y[j].y) + (y[j].z * y[j].z + y[j].w * y[j].w); }
        const float rstd = 1.f / sqrtf(wave_sum(s) * (1.f / DM) + EPS); float s2 = 0.f;
        GAS f32x4* orow = (GAS f32x4*)(out + (size_t)m * DM) + lane;
#pragma unroll
        for (int j = 0; j < 4; ++j) { xb[j] = xb[j] + y[j] * rstd * gp[j]; orow[64 * j] = xb[j]; s2 += (xb[j].x * xb[j].x + xb[j].y * xb[j].y) + (xb[j].z * xb[j].z + xb[j].w * xb[j].w); }
        if (write_xn) { const float r2 = 1.f / sqrtf(wave_sum(s2) * (1.f / DM) + EPS); GAS unsigned long long* o8 = (GAS unsigned long long*)(XN + (size_t)m * DM) + lane;
#pragma unroll
            for (int j = 0; j < 4; ++j) o8[64 * j] = (unsigned long long)pkbf(xb[j].x * r2, xb[j].y * r2) | ((unsigned long long)pkbf(xb[j].z * r2, xb[j].w * r2) << 32); }
    }
}

__device__ __forceinline__ void combine_phase(const bf16* O0, bf16* O1, const bf16* Gt, const float* gsub, float lam, float oml, int gw, int NGW, int lane) {
    float gs[16];
#pragma unroll
    for (int i = 0; i < 16; ++i) gs[i] = gsub[((lane & 7) * 16 + i)] * oml;
    for (int m = gw; m < M; m += NGW) {
        const size_t off = (size_t)m * DM + lane * 16;
        const v4u a0 = *(const GAS v4u*)(O0 + off), a1 = *(const GAS v4u*)(O0 + off + 8), b0 = *(const GAS v4u*)(O1 + off), b1 = *(const GAS v4u*)(O1 + off + 8), g0 = *(const GAS v4u*)(Gt + off), g1 = *(const GAS v4u*)(Gt + off + 8);
        float d[16], gg[16];
        const unsigned aw[8] = {a0.x, a0.y, a0.z, a0.w, a1.x, a1.y, a1.z, a1.w}, bw[8] = {b0.x, b0.y, b0.z, b0.w, b1.x, b1.y, b1.z, b1.w}, gw8[8] = {g0.x, g0.y, g0.z, g0.w, g1.x, g1.y, g1.z, g1.w};
        float ss = 0.f;
#pragma unroll
        for (int i = 0; i < 8; ++i) { d[2 * i] = pg8::bflo(aw[i]) - lam * pg8::bflo(bw[i]); d[2 * i + 1] = pg8::bfhi(aw[i]) - lam * pg8::bfhi(bw[i]); gg[2 * i] = pg8::bflo(gw8[i]); gg[2 * i + 1] = pg8::bfhi(gw8[i]);
            ss += d[2 * i] * d[2 * i] + d[2 * i + 1] * d[2 * i + 1]; }
        ss += __shfl_xor(ss, 1); ss += __shfl_xor(ss, 2); ss += __shfl_xor(ss, 4);
        const float rstd = 1.f / sqrtf(ss * (1.f / 128.f) + EPS);
        unsigned o[8];
#pragma unroll
        for (int i = 0; i < 8; ++i) o[i] = pkbf(d[2 * i] * rstd * gs[2 * i] * gg[2 * i], d[2 * i + 1] * rstd * gs[2 * i + 1] * gg[2 * i + 1]);
        *(GAS v4u*)(O1 + off) = (v4u){o[0], o[1], o[2], o[3]}; *(GAS v4u*)(O1 + off + 8) = (v4u){o[4], o[5], o[6], o[7]};
    }
}

constexpr int N_PHASES = 23;
__host__ __device__ constexpr int phase_kind(int ph) { return ph == 0 ? 0 : ph <= 12 ? 1 + (ph - 1) % 6 : ((ph - 13) % 5 == 4 ? 6 : 7 + (ph - 13) % 5); }
#ifndef PHMASK
#define PHMASK 0xffff
#endif
#define PH_ON(k) ((SEL < 0 && ((PHMASK >> (k)) & 1)) || SEL == (k))
template <int SEL> __global__ void __launch_bounds__(NWAVES * 64, 2) mk_fwd(Args A) {
    extern __shared__ __attribute__((aligned(16))) unsigned char lds_raw[];
    LAS unsigned char* lds = (LAS unsigned char*)lds_raw;
    const int tid = threadIdx.x, lane = tid & 63, wave = __builtin_amdgcn_readfirstlane(tid >> 6);
    const int G = gridDim.x, bx = blockIdx.x, vcu = (G % 8 == 0) ? (bx % 8) * (G / 8) + bx / 8 : bx;
    const int gw = vcu * NWAVES + wave, NGW = G * NWAVES;
    gu32* ctl = (gu32*)(A.ws + WS_CTL);
    for (int u = tid; u < (LDS_BYTES - LDSCTL_OFF) / 4; u += NWAVES * 64) ((LAS unsigned*)(lds + LDSCTL_OFF))[u] = 0u;
    __syncthreads();
    XcdBarrier bar; bar.bar = (unsigned*)(ctl + CW_BAR); bar.x = 0; bar.st = nullptr;
    if (A.use_bar) bar = xcd_barrier_post((unsigned*)(ctl + CW_BAR), (volatile LAS unsigned*)(lds + MISC_OFF) + 8);

#define WSP(T, off) ((T*)(ws_ + (off)))
#ifndef REPMASK
#define REPMASK 0
#endif
#define PH_BEGIN(k) if (A.ph_lo <= (k) && (k) < A.ph_hi) for (int rep_ = 0; rep_ <= ((REPMASK >> phase_kind(k)) & 1); ++rep_) { int tid = threadIdx.x; asm volatile("" : "+v"(tid)); const int lane = tid & 63; unsigned char* ws_ = A.ws; asm volatile("" : "+s"(ws_)); (void)lane; (void)ws_;
#define PH_END(k) if (A.use_bar && ((k) + 1 < A.ph_hi || rep_ < ((REPMASK >> phase_kind(k)) & 1))) xcd_barrier(bar); }
    const size_t MB1 = (size_t)M * 1024;
    PH_BEGIN(0) if (PH_ON(0)) p0_prologue(A, lds, vcu, G, wave, lane, tid); PH_END(0)
#pragma unroll 1
    for (int l = 0; l < 2; ++l) {
        const int pb = 1 + 6 * l;
        PH_BEGIN(pb + 0) if (PH_ON(1)) { pg8::Gemm g{WSP(bf16, WS_XN), WSP(bf16, WS_WINA) + (size_t)l * 6144 * 1024, M, 4096, 1024}; pg8::StaticOrder S; S.init(M, 4096, G, bx);
            pg8::EpiRet E{WSP(bf16, WS_R), WSP(bf16, WS_R) + MB1, WSP(bf16, WS_R) + 2 * MB1, WSP(float, WS_CS128), WSP(float, WS_MISC)};
            pg8::gemm_phase<pg8::EpiRet, pg8::StaticOrder, true, true>(lds + RING_OFF, g, S, E); } PH_END(pb + 0)
        PH_BEGIN(pb + 1) if (PH_ON(2)) { ret::Bufs B{WSP(bf16, WS_R), WSP(bf16, WS_R) + MB1, WSP(bf16, WS_R) + 2 * MB1, WSP(float, WS_L), WSP(float, WS_MISC)};
            for (int u = vcu; u < 256; u += G) if ((u & 15) != 15) ret::r1_unit(lds + RING_OFF, B, u); } PH_END(pb + 1)
        PH_BEGIN(pb + 2) if (PH_ON(3)) { ret::Bufs B{WSP(bf16, WS_R), WSP(bf16, WS_R) + MB1, WSP(bf16, WS_R) + 2 * MB1, WSP(float, WS_L), WSP(float, WS_MISC)};
            for (int u = vcu; u < 256; u += G) ret::r3_unit(lds + RING_OFF, B, u); } PH_END(pb + 2)
        PH_BEGIN(pb + 3) if (PH_ON(4)) { pg8::Gemm g{WSP(bf16, WS_XN), WSP(bf16, WS_WINA) + (size_t)l * 6144 * 1024 + (size_t)4096 * 1024, M, 2048, 1024}; pg8::StaticOrder S; S.init(M, 2048, G, bx);
            pg8::EpiGate E{WSP(bf16, WS_R) + 2 * MB1};
            pg8::gemm_phase<pg8::EpiGate, pg8::StaticOrder, true, true>(lds + RING_OFF, g, S, E); } PH_END(pb + 3)
        PH_BEGIN(pb + 4) if (PH_ON(5)) { pg8::Gemm g{WSP(bf16, WS_R) + 2 * MB1, WSP(bf16, WS_WOUTA) + (size_t)l * 1024 * 2048, M, 1024, 2048}; pg8::StaticOrder S; S.init(M, 1024, G, bx);
            pg8::EpiY E{WSP(float, WS_R), 1024};
            pg8::gemm_phase<pg8::EpiY, pg8::StaticOrder, true, true>(lds + RING_OFF, g, S, E); } PH_END(pb + 4)
        PH_BEGIN(pb + 5) if (PH_ON(6)) norm_phase(WSP(float, WS_R), l == 0 ? A.x : A.out, A.post_norm + l * 1024, A.out, WSP(bf16, WS_XN), true, gw, NGW, lane); PH_END(pb + 5)
    }
#pragma unroll 1
    for (int j = 0; j < 2; ++j) {
        const int pb = 13 + 5 * j;
        PH_BEGIN(pb + 0) if (PH_ON(7)) { pg8::Gemm g{WSP(bf16, WS_XN), j == 0 ? WSP(bf16, WS_WKVQ) : WSP(bf16, WS_W3), M, j == 0 ? 4096 : 2048, 1024}; pg8::StaticOrder S; S.init(M, g.N, G, bx);
            pg8::EpiDiff E{WSP(bf16, WS_R), WSP(bf16, WS_R) + MB1, WSP(bf16, WS_R) + 2 * MB1, WSP(bf16, WS_R) + 3 * MB1, WSP(float, WS_CS64), j == 0 ? 0 : 8, C2};
            pg8::gemm_phase<pg8::EpiDiff, pg8::StaticOrder, true, true>(lds + RING_OFF, g, S, E); } PH_END(pb + 0)
        PH_BEGIN(pb + 1) if (PH_ON(8)) { const attn_body::AttnTensors AT{WSP(const attn_body::bf16, WS_R) + 2 * MB1, WSP(const attn_body::bf16, WS_R), WSP(const attn_body::bf16, WS_R) + MB1, WSP(attn_body::bf16, WS_XN), WSP(attn_body::bf16, WS_L)};
            const attn_body::StaticOrder S(G, bx);
            attn_body::attn_phase<attn_body::StaticOrder>((char*)lds_raw + RING_OFF, AT, S); } PH_END(pb + 1)
        PH_BEGIN(pb + 2) if (PH_ON(9)) combine_phase(WSP(bf16, WS_XN), WSP(bf16, WS_L), WSP(bf16, WS_R) + 3 * MB1, A.sub_norm_b + j * 128, WSP(float, WS_MISC)[16 + j], 1.0f - (j == 0 ? LAMBDA_INIT2 : LAMBDA_INIT3), gw, NGW, lane); PH_END(pb + 2)
        PH_BEGIN(pb + 3) if (PH_ON(10)) { pg8::Gemm g{WSP(bf16, WS_L), WSP(bf16, WS_WOUTB) + (size_t)j * 1024 * 1024, M, 1024, 1024}; pg8::StaticOrder S; S.init(M, 1024, G, bx);
            pg8::EpiY E{WSP(float, WS_R + 64 * MiB), 1024};
            pg8::gemm_phase<pg8::EpiY, pg8::StaticOrder, true, true>(lds + RING_OFF, g, S, E); } PH_END(pb + 3)
        PH_BEGIN(pb + 4) if (PH_ON(6)) norm_phase(WSP(float, WS_R + 64 * MiB), A.out, A.post_norm + (2 + j) * 1024, A.out, WSP(bf16, WS_XN), j == 0, gw, NGW, lane); PH_END(pb + 4)
    }
}

#ifndef MK_FUSED
#define MK_FUSED 1
#endif
#if !MK_FUSED
typedef void (*kern_t)(Args);
static int phase_sel(int ph) {
    if (ph == 0) return 0;
    if (ph <= 12) return 1 + (ph - 1) % 6;
    const int k = (ph - 13) % 5; return k == 4 ? 6 : 7 + k;
}
static kern_t sel_kernel(int sel) {
    switch (sel) { case 0: return mk_fwd<0>; case 1: return mk_fwd<1>; case 2: return mk_fwd<2>; case 3: return mk_fwd<3>; case 4: return mk_fwd<4>; case 5: return mk_fwd<5>;
                   case 6: return mk_fwd<6>; case 7: return mk_fwd<7>; case 8: return mk_fwd<8>; case 9: return mk_fwd<9>; default: return mk_fwd<10>; }
}
#endif
extern "C" void kernel_launch(void* const* d_in, const int* in_sizes, int n_in, void* d_out, int out_size, void* d_ws, size_t ws_size, hipStream_t stream) {
    static int grid = 0;
    if (grid == 0) {
        if (n_in != 14 || out_size != M * DM || ws_size < WS_END) { fprintf(stderr, "kernel_launch: unexpected shapes (n_in %d out %d ws %zu)\n", n_in, out_size, ws_size); grid = -1; return; }
        int dev = 0, cus = 0;
        if (hipGetDevice(&dev) != hipSuccess || hipDeviceGetAttribute(&cus, hipDeviceAttributeMultiprocessorCount, dev) != hipSuccess) { grid = -1; return; }
#if MK_FUSED
        if (hipFuncSetAttribute((const void*)mk_fwd<-1>, hipFuncAttributeMaxDynamicSharedMemorySize, LDS_BYTES) != hipSuccess) { fprintf(stderr, "kernel_launch: hipFuncSetAttribute failed\n"); grid = -1; return; }
#else
        for (int k = 0; k <= 10; ++k) if (hipFuncSetAttribute((const void*)sel_kernel(k), hipFuncAttributeMaxDynamicSharedMemorySize, LDS_BYTES) != hipSuccess) { fprintf(stderr, "kernel_launch: hipFuncSetAttribute failed\n"); grid = -1; return; }
#endif
        (void)hipGetLastError();
        grid = cus;
    }
    if (grid < 0) return;
    (void)hipMemsetAsync((char*)d_ws + WS_CTL, 0, CTL_ZERO_BYTES, stream);
    Args a{};
    a.x = (const float*)d_in[0]; a.pre_norm = (const float*)d_in[1]; a.post_norm = (const float*)d_in[2]; a.w_in_a = (const float*)d_in[3]; a.w_out_a = (const float*)d_in[4];
    a.kv_norm = (const float*)d_in[5]; a.w_kv = (const float*)d_in[6]; a.w_in_b = (const float*)d_in[7]; a.lam_q1 = (const float*)d_in[8]; a.lam_k1 = (const float*)d_in[9];
    a.lam_q2 = (const float*)d_in[10]; a.lam_k2 = (const float*)d_in[11]; a.sub_norm_b = (const float*)d_in[12]; a.w_out_b = (const float*)d_in[13];
    a.out = (float*)d_out; a.ws = (unsigned char*)d_ws;
#if MK_FUSED
    a.ph_lo = 0; a.ph_hi = N_PHASES; a.use_bar = 1;
    hipLaunchKernelGGL(mk_fwd<-1>, dim3(grid), dim3(NWAVES * 64), LDS_BYTES, stream, a);
#else
    for (int ph = 0; ph < N_PHASES; ++ph) { a.ph_lo = ph; a.ph_hi = ph + 1; a.use_bar = 0; hipLaunchKernelGGL(sel_kernel(phase_sel(ph)), dim3(grid), dim3(NWAVES * 64), LDS_BYTES, stream, a); }
#endif
}
```
